# Optimizing an MI355X kernel written in HIP

```python
import math
import jax, jax.numpy as jnp
from jax import lax
import numpy as np

D_MODEL = 1024
BATCH = 8
SEQ = 2048
DEPTH = 1
DEC_BATCH = 8
DEC_SEQ = 64
PAST_LEN = 4096

CHUNK = 64
Q_BLOCK = 128
H_A = 4
DK_A = 64
DV_A = 2 * DK_A
W_A = H_A * DV_A
H_B = 4
DK_B = 128
DV_B = 128
W_B = H_B * DV_B
QK_A = H_A * 2 * DK_A
QK_B = H_B * DK_B
W_IN = 2 * QK_A + 2 * W_A + 2 * QK_B + 2 * W_B + 2 * D_MODEL
EPS = 1e-6

kernel_name = "hybrid_diffattn_retention_stream_step"


def _split_points():
    sizes = [QK_A, QK_A, W_A, W_A, QK_B, QK_B, W_B, W_B, D_MODEL, D_MODEL]
    pts, acc = [], 0
    for s in sizes[:-1]:
        acc += s
        pts.append(acc)
    return pts


def rmsnorm(x, g=None):
    xf = x.astype(jnp.float32)
    y = xf * lax.rsqrt(jnp.mean(xf * xf, axis=-1, keepdims=True) + EPS)
    if g is not None:
        y = y * g.astype(jnp.float32)
    return y.astype(x.dtype)


def alibi_slopes():
    return 2.0 ** (-8.0 * jnp.arange(1, H_A + 1, dtype=jnp.float32) / H_A)


def retention_log_decay():
    return jnp.log(1.0 - 2.0 ** (-5.0 - jnp.arange(H_B, dtype=jnp.float32)))


def diff_attention(q, k, v, q_pos, k_pos, lam, slopes):
    s = jnp.einsum('bqhcd,bkhcd->bhcqk', q, k).astype(jnp.float32) * (DK_A ** -0.5)
    dist = jnp.abs(q_pos[:, None] - k_pos[None, :]).astype(jnp.float32)
    s = s - slopes[None, :, None, None, None] * dist[None, None, None]
    allowed = (k_pos[None, :] // CHUNK) <= (q_pos[:, None] // CHUNK)
    s = jnp.where(allowed[None, None, None], s, -jnp.inf)
    p = jax.nn.softmax(s, axis=-1)
    a = p[:, :, 0] - lam * p[:, :, 1]
    return jnp.einsum('bhqk,bkhe->bqhe', a.astype(v.dtype), v)


def diff_attn_prompt(q, k, v, lam, slopes):
    B, T = q.shape[0], q.shape[1]
    nb = T // Q_BLOCK
    qb = q.reshape(B, nb, Q_BLOCK, H_A, 2, DK_A).swapaxes(0, 1)
    starts = jnp.arange(nb, dtype=jnp.int32) * Q_BLOCK
    k_pos = jnp.arange(T, dtype=jnp.int32)

    def block(args):
        qi, st = args
        return diff_attention(qi, k, v, st + jnp.arange(Q_BLOCK, dtype=jnp.int32), k_pos, lam, slopes)

    o = lax.map(block, (qb, starts))
    return o.swapaxes(0, 1).reshape(B, T, H_A, DV_A)


def diff_attn_step(q, k_all, v_all, past, lam, slopes):
    n = q.shape[1]
    q_pos = past + jnp.arange(n, dtype=jnp.int32)
    k_pos = jnp.arange(k_all.shape[1], dtype=jnp.int32)
    return diff_attention(q, k_all, v_all, q_pos, k_pos, lam, slopes)


def retention_prompt(q, k, v, log_g):
    B, T = q.shape[0], q.shape[1]
    nc = T // CHUNK
    qc = q.reshape(B, nc, CHUNK, H_B, DK_B)
    kc = k.reshape(B, nc, CHUNK, H_B, DK_B)
    vc = v.reshape(B, nc, CHUNK, H_B, DV_B)
    j = jnp.arange(CHUNK, dtype=jnp.float32)
    d_intra = jnp.exp(jnp.abs(j[:, None] - j[None, :])[None] * log_g[:, None, None])
    s = jnp.einsum('bnthd,bnshd->bnhts', qc, kc) * d_intra
    intra = jnp.einsum('bnhts,bnshe->bnthe', s, vc)
    zeta = jnp.exp((CHUNK - 1 - j)[None] * log_g[:, None])
    u = jnp.einsum('bnshd,bnshe,hs->nbhde', kc, vc, zeta)
    decay_c = jnp.exp(CHUNK * log_g)[None, :, None, None]

    def step(r, u_n):
        return decay_c * r + u_n, r

    r0 = jnp.zeros((B, H_B, DK_B, DV_B), jnp.float32)
    r_final, r_before = lax.scan(step, r0, u)
    xi = jnp.exp((j + 1.0)[None] * log_g[:, None])
    cross = jnp.einsum('bnthd,nbhde,ht->bnthe', qc, r_before, xi)
    o = (intra + cross).reshape(B, T, H_B, DV_B)
    return o.astype(q.dtype), r_final


def retention_step(q, k, v, r, log_g):
    n = q.shape[1]
    j = jnp.arange(n, dtype=jnp.float32)
    d = jnp.exp(jnp.abs(j[:, None] - j[None, :])[None] * log_g[:, None, None])
    s = jnp.einsum('bthd,bshd->bhts', q, k) * d
    intra = jnp.einsum('bhts,bshe->bthe', s, v)
    xi = jnp.exp((j + 1.0)[None] * log_g[:, None])
    rf = r.astype(jnp.float32)
    cross = jnp.einsum('bthd,bhde,ht->bthe', q, rf, xi)
    zeta = jnp.exp((n - 1.0 - j)[None] * log_g[:, None])
    r_new = jnp.exp(n * log_g)[None, :, None, None] * rf + jnp.einsum('bshd,bshe,hs->bhde', k, v, zeta)
    return (intra + cross).astype(q.dtype), r_new.astype(r.dtype)


def layer_inputs(x, norm_g, w_in, b_gate, qn_g, kn_g):
    B, T = x.shape[0], x.shape[1]
    h = rmsnorm(x, norm_g) @ w_in
    qa, ka, va, za, qb, kb, vb, zb, ga, gb = jnp.split(h, _split_points(), axis=-1)
    qa = rmsnorm(qa.reshape(B, T, H_A, 2, DK_A), qn_g)
    ka = rmsnorm(ka.reshape(B, T, H_A, 2, DK_A), kn_g)
    va = va.reshape(B, T, H_A, DV_A)
    qb = qb.reshape(B, T, H_B, DK_B)
    kb = kb.reshape(B, T, H_B, DK_B) * (DK_B ** -0.5)
    vb = vb.reshape(B, T, H_B, DV_B)
    ga = jax.nn.sigmoid(ga + b_gate[0])
    gb = jax.nn.sigmoid(gb + b_gate[1])
    return qa, ka, va, za, qb, kb, vb, zb, ga, gb


def layer_output(x, oa, ob, za, zb, ga, gb, subln_g, lam_init, w_oa, w_ob, w_out):
    B, T = x.shape[0], x.shape[1]
    oa = (rmsnorm(oa, subln_g) * (1.0 - lam_init)).reshape(B, T, W_A) * jax.nn.silu(za)
    ob = rmsnorm(ob).reshape(B, T, W_B) * jax.nn.silu(zb)
    m = ga * (oa @ w_oa) + gb * (ob @ w_ob)
    return x + m @ w_out


def setup_inputs(seed: int = 0) -> dict:
    key = jax.random.key(seed)
    ks = jax.random.split(key, 20)
    f32 = jnp.float32
    nrm = lambda k, shape: jax.random.normal(k, shape, f32)
    return {
        "x_prompt": nrm(ks[0], (BATCH, SEQ, D_MODEL)),
        "x_sample": nrm(ks[1], (DEC_BATCH, DEC_SEQ, D_MODEL)),
        "cache_k_diff": nrm(ks[2], (DEPTH, DEC_BATCH, PAST_LEN, H_A, 2, DK_A)),
        "cache_v_diff": nrm(ks[3], (DEPTH, DEC_BATCH, PAST_LEN, H_A, DV_A)),
        "state_ret": nrm(ks[4], (DEPTH, DEC_BATCH, H_B, DK_B, DV_B)),
        "norm_g": 1.0 + 0.02 * nrm(ks[5], (DEPTH, D_MODEL)),
        "w_in": nrm(ks[6], (DEPTH, D_MODEL, W_IN)) * D_MODEL ** -0.5,
        "b_gate": 0.01 * nrm(ks[7], (DEPTH, 2, D_MODEL)),
        "qn_g": 1.0 + 0.02 * nrm(ks[8], (DEPTH, DK_A)),
        "kn_g": 1.0 + 0.02 * nrm(ks[9], (DEPTH, DK_A)),
        "lam_q1": 0.1 * nrm(ks[10], (DEPTH, DK_A)),
        "lam_k1": 0.1 * nrm(ks[11], (DEPTH, DK_A)),
        "lam_q2": 0.1 * nrm(ks[12], (DEPTH, DK_A)),
        "lam_k2": 0.1 * nrm(ks[13], (DEPTH, DK_A)),
        "subln_g": 1.0 + 0.02 * nrm(ks[14], (DEPTH, DV_A)),
        "w_o_diff": nrm(ks[15], (DEPTH, W_A, D_MODEL)) * W_A ** -0.5,
        "w_o_ret": nrm(ks[16], (DEPTH, W_B, D_MODEL)) * W_B ** -0.5,
        "w_out": nrm(ks[17], (DEPTH, D_MODEL, D_MODEL)) * D_MODEL ** -0.5,
    }


def reference(x_prompt, x_sample, cache_k_diff, cache_v_diff, state_ret, norm_g, w_in, b_gate,
              qn_g, kn_g, lam_q1, lam_k1, lam_q2, lam_k2, subln_g, w_o_diff, w_o_ret, w_out):
    slopes = alibi_slopes()
    log_g = retention_log_decay()
    past = cache_k_diff.shape[2]
    hp, hs = x_prompt, x_sample
    kp_l, vp_l, rp_l, ks_l, vs_l, rs_l = [], [], [], [], [], []
    for l in range(DEPTH):
        lam_init = 0.8 - 0.6 * math.exp(-0.3 * l)
        lam = (jnp.exp(jnp.sum(lam_q1[l] * lam_k1[l]).astype(jnp.float32))
               - jnp.exp(jnp.sum(lam_q2[l] * lam_k2[l]).astype(jnp.float32)) + lam_init)
        qa, ka, va, za, qb, kb, vb, zb, ga, gb = layer_inputs(hp, norm_g[l], w_in[l], b_gate[l], qn_g[l], kn_g[l])
        oa = diff_attn_prompt(qa, ka, va, lam, slopes)
        ob, r_p = retention_prompt(qb, kb, vb, log_g)
        hp = layer_output(hp, oa, ob, za, zb, ga, gb, subln_g[l], lam_init, w_o_diff[l], w_o_ret[l], w_out[l])
        kp_l.append(ka)
        vp_l.append(va)
        rp_l.append(r_p)
        qa, ka, va, za, qb, kb, vb, zb, ga, gb = layer_inputs(hs, norm_g[l], w_in[l], b_gate[l], qn_g[l], kn_g[l])
        k_all = jnp.concatenate([cache_k_diff[l].astype(ka.dtype), ka], axis=1)
        v_all = jnp.concatenate([cache_v_diff[l].astype(va.dtype), va], axis=1)
        oa = diff_attn_step(qa, k_all, v_all, past, lam, slopes)
        ob, r_s = retention_step(qb, kb, vb, state_ret[l], log_g)
        hs = layer_output(hs, oa, ob, za, zb, ga, gb, subln_g[l], lam_init, w_o_diff[l], w_o_ret[l], w_out[l])
        ks_l.append(ka)
        vs_l.append(va)
        rs_l.append(r_s)
    k_prompt = jnp.stack(kp_l)
    v_prompt = jnp.stack(vp_l)
    ret_prompt = jnp.stack(rp_l)
    k_sample = jnp.stack(ks_l)
    v_sample = jnp.stack(vs_l)
    ret_sample = jnp.stack(rs_l)
    return (hp, hs, k_prompt, v_prompt, ret_prompt, k_sample, v_sample, ret_sample)
```

```cpp
#include <hip/hip_runtime.h>
#include <hip/hip_cooperative_groups.h>
#include <cstdio>
#include <cstdint>
namespace cg = cooperative_groups;

#define LAS __attribute__((address_space(3)))
typedef unsigned short bf16_t;
typedef short bf16x8 __attribute__((ext_vector_type(8)));
typedef float f32x4 __attribute__((ext_vector_type(4)));
typedef float f32x16 __attribute__((ext_vector_type(16)));
typedef unsigned u32x4 __attribute__((ext_vector_type(4)));
typedef unsigned u32x2 __attribute__((ext_vector_type(2)));

constexpr int DM = 1024, SEQ = 2048, PAST = 4096;
constexpr int MP = 8 * SEQ, MS = 8 * 64, MT = MP + MS;
constexpr int WIN = 6144;
constexpr float EPS = 1e-6f;
constexpr float LOG2E = 1.4426950408889634f;
constexpr int GC = 8, NG = 32 / GC;
constexpr int NSPLIT = 6;
__host__ __device__ constexpr int nsplit_of(int h) { return h == 0 ? 2 : h == 1 ? 4 : 9; }
__host__ __device__ constexpr int slot_of(int h) { return h == 0 ? 0 : h == 1 ? 2 : h == 2 ? 6 : 15; }

constexpr size_t O_YP = 0, O_YS = 16777216, O_KP = 17301504, O_VP = 25690112, O_RP = 34078720, O_KS = 34603008, O_VS = 34865152, O_RS = 35127296;

constexpr size_t SZ_H = (size_t)MT * 512 * 2;
constexpr size_t W_XN = 0;
constexpr size_t W_OAN = 0, W_OBN = SZ_H;
constexpr size_t W_RSTD = 2 * SZ_H;
constexpr size_t W_WINT = W_RSTD + 67584;
constexpr size_t W_WOAT = W_WINT + (size_t)6144 * 1024 * 2;
constexpr size_t W_WOBT = W_WOAT + 1048576;
constexpr size_t W_WOUTT = W_WOBT + 1048576;
constexpr size_t W_QA = W_WOUTT + 2097152;
constexpr size_t W_KA = W_QA + SZ_H;
constexpr size_t W_MB = W_QA;
constexpr size_t W_VAT = W_KA + SZ_H;
constexpr size_t W_SZA = W_VAT + SZ_H;
constexpr size_t W_QB = W_SZA + SZ_H;
constexpr size_t W_KB = W_QB + SZ_H;
constexpr size_t W_KBT = W_KB + SZ_H;
constexpr size_t W_VBT = W_KBT + SZ_H;
constexpr size_t W_SZB = W_VBT + SZ_H;
constexpr size_t W_GAS = W_SZB + SZ_H;
constexpr size_t W_GBS = W_GAS + 1048576;
constexpr size_t W_PO = W_WINT;
constexpr size_t W_PL = W_GBS + 1048576;
constexpr size_t W_CTR = W_PL + (size_t)32 * NSPLIT * 2 * 64 * 4;
constexpr size_t W_BAR = W_CTR + 256;
constexpr size_t W_OP = W_BAR + 3456 * 4;
constexpr size_t W_UG = W_OP + (size_t)MP * 512 * 4;
constexpr size_t W_END = W_UG + (size_t)32 * 8 * 128 * 128 * 4;
static_assert((size_t)32 * NSPLIT * 2 * 64 * 128 * 4 <= (size_t)6144 * 1024 * 2, "split partials must fit the WinT region");
static_assert(W_END <= (size_t)268435456, "workspace map exceeds 256 MiB");
constexpr size_t TSAMP = (size_t)8 * 4 * 128 * 2048;

constexpr int SMEM = 72192;
constexpr int SM_FLAG = 71680;

struct Params {
    const float *x_prompt, *x_sample, *cache_k, *cache_v, *state_ret, *norm_g, *w_in, *b_gate, *qn_g, *kn_g;
    const float *lam_q1, *lam_k1, *lam_q2, *lam_k2, *subln_g, *w_oa, *w_ob, *w_out;
    float* out;
    unsigned char* ws;
};

typedef float f32x2 __attribute__((ext_vector_type(2)));
typedef __bf16 bf16x2n __attribute__((ext_vector_type(2)));
__device__ __forceinline__ unsigned cvt_pk_bf16(float lo, float hi) { const f32x2 v = {lo, hi}; return __builtin_bit_cast(unsigned, __builtin_convertvector(v, bf16x2n)); }
__device__ __forceinline__ int opaque_tid() { int t = threadIdx.x; asm volatile("" : "+v"(t)); return t; }
__device__ __forceinline__ float bflo(unsigned u) { return __uint_as_float(u << 16); }
__device__ __forceinline__ float bfhi(unsigned u) { return __uint_as_float(u & 0xffff0000u); }
__device__ __forceinline__ bf16_t f2bf(float f) { return (bf16_t)(cvt_pk_bf16(f, 0.f) & 0xffffu); }
__device__ __forceinline__ float fexp2(float x) { return __builtin_amdgcn_exp2f(x); }
__device__ __forceinline__ float frcp(float x) { return __builtin_amdgcn_rcpf(x); }
__device__ __forceinline__ float sigmoidf_(float x) { return frcp(1.0f + fexp2(-LOG2E * x)); }
__device__ __forceinline__ f32x16 mfma32(bf16x8 a, bf16x8 b, f32x16 c) { return __builtin_amdgcn_mfma_f32_32x32x16_bf16(a, b, c, 0, 0, 0); }
__device__ __forceinline__ f32x4 mfma16(bf16x8 a, bf16x8 b, f32x4 c) { return __builtin_amdgcn_mfma_f32_16x16x32_bf16(a, b, c, 0, 0, 0); }
__device__ __forceinline__ bf16x8 pack8(const f32x16& s, int st) {
    u32x4 w;
    w.x = cvt_pk_bf16(s[8 * st + 0], s[8 * st + 1]); w.y = cvt_pk_bf16(s[8 * st + 2], s[8 * st + 3]);
    w.z = cvt_pk_bf16(s[8 * st + 4], s[8 * st + 5]); w.w = cvt_pk_bf16(s[8 * st + 6], s[8 * st + 7]);
    return __builtin_bit_cast(bf16x8, w);
}
__device__ __forceinline__ bf16x8 lds_rd16(const LAS unsigned char* p) { return *(const LAS bf16x8*)p; }
__device__ __forceinline__ bf16x8 lds_rd8x2(const LAS unsigned char* p) {
    u32x2 a = *(const LAS u32x2*)p, b = *(const LAS u32x2*)(p + 16);
    u32x4 w; w.x = a.x; w.y = a.y; w.z = b.x; w.w = b.y; return __builtin_bit_cast(bf16x8, w);
}
__device__ __forceinline__ bf16x8 lds_rd8c(const LAS unsigned char* p) {
    u32x2 a = *(const LAS u32x2*)p, b = *(const LAS u32x2*)(p + 8);
    u32x4 w; w.x = a.x; w.y = a.y; w.z = b.x; w.w = b.y; return __builtin_bit_cast(bf16x8, w);
}
__device__ __forceinline__ float log2_gamma(int h) { return log2f(1.0f - exp2f(-5.0f - (float)h)); }
__device__ __forceinline__ int accrow(int g, int hh) { return (g & 3) + 8 * (g >> 2) + 4 * hh; }
__device__ __forceinline__ int pi32(int r) { return (r & 19) | ((r & 4) << 1) | ((r & 8) >> 1); }
__device__ __forceinline__ int prow(int g, int hh) { return (g & 3) + 4 * ((g >> 2) & 1) + 8 * hh + 16 * (g >> 3); }

__device__ __forceinline__ int lds_byte(int r, int c) { const int st = (r >> 4) * 2 + (c >> 5), rr = r & 15, cc = c & 31, ob = rr * 64 + cc * 2; return st * 1024 + (ob ^ (((ob >> 9) & 1) << 5)); }
__device__ __forceinline__ void stage_rc(int b, int& R, int& C) { const int st = b / 1024, sb = b % 1024, swz = sb ^ (((sb >> 9) & 1) << 5); R = (st >> 1) * 16 + swz / 64; C = (st & 1) * 32 + (swz % 64) / 2; }

__device__ __forceinline__ void gemm_accum(f32x4 (&acc)[4][4], const bf16_t* __restrict__ A, int lda, const bf16_t* __restrict__ Bt, int ldb, int K, LAS unsigned char* lds) {
    const int tid = opaque_tid(), wid = __builtin_amdgcn_readfirstlane(tid >> 6), lane = tid & 63, wr = wid >> 1, wc = wid & 1, fr = lane & 15, fq = lane >> 4;
    unsigned offA[4], offB[4];
#pragma unroll
    for (int i = 0; i < 4; ++i) { const int R = (wid + 4 * i) * 8 + (lane >> 3), c = (lane & 7) ^ ((R >> 1) & 7); offA[i] = (unsigned)(R * lda + c * 8) * 2u; offB[i] = (unsigned)(R * ldb + c * 8) * 2u; }
    const int fo0 = fr * 128 + ((fq ^ (fr >> 1)) << 4), fo1 = fo0 ^ 64;
    const int aoff = wr * 8192, boff = 16384 + wc * 8192;
    const int nk = K >> 6;
    __syncthreads();
#define GEMM_STAGE(kt, buf) do { LAS unsigned char* la_ = lds + (buf) * 32768 + wid * 1024; \
        _Pragma("unroll") for (int i_ = 0; i_ < 4; ++i_) __builtin_amdgcn_global_load_lds((const unsigned*)((const char*)A + offA[i_] + (size_t)(kt) * 128), (LAS unsigned*)(la_ + i_ * 4096), 16, 0, 0); \
        _Pragma("unroll") for (int i_ = 0; i_ < 4; ++i_) __builtin_amdgcn_global_load_lds((const unsigned*)((const char*)Bt + offB[i_] + (size_t)(kt) * 128), (LAS unsigned*)(la_ + 16384 + i_ * 4096), 16, 0, 0); } while (0)
    GEMM_STAGE(0, 0);
    for (int kt = 0; kt < nk; ++kt) {
        asm volatile("s_waitcnt vmcnt(0)" ::: "memory");
        __syncthreads();
        if (kt + 1 < nk) GEMM_STAGE(kt + 1, (kt + 1) & 1);
        const LAS unsigned char* ps = lds + (kt & 1) * 32768;
        bf16x8 af[4][2], bfr[4][2];
#pragma unroll
        for (int m = 0; m < 4; ++m) { af[m][0] = lds_rd16(ps + aoff + m * 2048 + fo0); af[m][1] = lds_rd16(ps + aoff + m * 2048 + fo1); }
#pragma unroll
        for (int n = 0; n < 4; ++n) { bfr[n][0] = lds_rd16(ps + boff + n * 2048 + fo0); bfr[n][1] = lds_rd16(ps + boff + n * 2048 + fo1); }
#pragma unroll
        for (int kk = 0; kk < 2; ++kk)
#pragma unroll
            for (int m = 0; m < 4; ++m)
#pragma unroll
                for (int n = 0; n < 4; ++n) acc[m][n] = mfma16(bfr[n][kk], af[m][kk], acc[m][n]);
    }
#undef GEMM_STAGE
}
__device__ __forceinline__ void acc_zero(f32x4 (&acc)[4][4]) {
#pragma unroll
    for (int m = 0; m < 4; ++m)
#pragma unroll
        for (int n = 0; n < 4; ++n) acc[m][n] = (f32x4){0.f, 0.f, 0.f, 0.f};
}

__device__ void phase0(const Params& p, LAS unsigned char* lds) {
    const int tid = opaque_tid(), wid = tid >> 6, lane = tid & 63;
    bf16_t* XN = (bf16_t*)(p.ws + W_XN); float* RSTD = (float*)(p.ws + W_RSTD);
    if (blockIdx.x == 0) {
        unsigned* ctr = (unsigned*)(p.ws + W_CTR);
        if (tid < 40) ctr[tid] = 0u;
        if (tid >= 56 && tid < 60) ctr[tid] = 0u;
        if (wid == 1) {
            float a = p.lam_q1[lane] * p.lam_k1[lane], b = p.lam_q2[lane] * p.lam_k2[lane];
            float gq = fabsf(p.qn_g[lane]), gk = fabsf(p.kn_g[lane]);
#pragma unroll
            for (int o = 32; o >= 1; o >>= 1) { a += __shfl_xor(a, o); b += __shfl_xor(b, o); gq = fmaxf(gq, __shfl_xor(gq, o)); gk = fmaxf(gk, __shfl_xor(gk, o)); }
            if (lane == 0) { float* sc = (float*)(p.ws + W_CTR); sc[40] = expf(a) - expf(b) + 0.2f; sc[41] = 8.0f * gq * gk * LOG2E; }
        }
    }
    const int gw = blockIdx.x * 4 + wid, nw = gridDim.x * 4;
    for (int row = gw; row < MT; row += nw) {
        const float* xr = row < MP ? p.x_prompt + (size_t)row * DM : p.x_sample + (size_t)(row - MP) * DM;
        f32x4 v[4]; float ss = 0.f;
#pragma unroll
        for (int i = 0; i < 4; ++i) { v[i] = *(const f32x4*)(xr + i * 256 + lane * 4); ss += v[i][0] * v[i][0] + v[i][1] * v[i][1] + v[i][2] * v[i][2] + v[i][3] * v[i][3]; }
#pragma unroll
        for (int o = 32; o >= 1; o >>= 1) ss += __shfl_xor(ss, o);
        if (lane == 0) RSTD[row] = rsqrtf(ss * (1.0f / 1024.0f) + EPS);
        f32x4 gn[4];
#pragma unroll
        for (int i = 0; i < 4; ++i) gn[i] = *(const f32x4*)(p.norm_g + i * 256 + lane * 4);
#pragma unroll
        for (int i = 0; i < 4; ++i) { const f32x4 g = gn[i]; u32x2 w; w.x = cvt_pk_bf16(v[i][0] * g[0], v[i][1] * g[1]); w.y = cvt_pk_bf16(v[i][2] * g[2], v[i][3] * g[3]);
            *(u32x2*)(XN + (size_t)row * DM + i * 256 + lane * 4) = w; }
    }
    LAS float* tile = (LAS float*)lds;
    const int tx = tid & 63, ty = tid >> 6;
    for (int t = blockIdx.x; t < 2048; t += gridDim.x) {
        const float* src; bf16_t* dst; int K, N, tt;
        if (t < 1536) { src = p.w_in; dst = (bf16_t*)(p.ws + W_WINT); K = 1024; N = 6144; tt = t; }
        else if (t < 1664) { src = p.w_oa; dst = (bf16_t*)(p.ws + W_WOAT); K = 512; N = 1024; tt = t - 1536; }
        else if (t < 1792) { src = p.w_ob; dst = (bf16_t*)(p.ws + W_WOBT); K = 512; N = 1024; tt = t - 1664; }
        else { src = p.w_out; dst = (bf16_t*)(p.ws + W_WOUTT); K = 1024; N = 1024; tt = t - 1792; }
        const int ntn = N >> 6, k0 = (tt / ntn) * 64, n0 = (tt % ntn) * 64;
        __syncthreads();
        float tv[16];
#pragma unroll
        for (int i = 0; i < 16; ++i) tv[i] = src[(size_t)(k0 + ty + 4 * i) * N + n0 + tx];
#pragma unroll
        for (int i = 0; i < 16; ++i) tile[(ty + 4 * i) * 65 + tx] = tv[i];
        __syncthreads();
#pragma unroll
        for (int i = 0; i < 16; ++i) dst[(size_t)(n0 + ty + 4 * i) * K + k0 + tx] = f2bf(tile[tx * 65 + ty + 4 * i]);
    }
}

__device__ __forceinline__ void epi_inproj(const Params& p, f32x4 (&acc)[4][4], int pm, int pn, LAS unsigned char* lds) {
    const int tid = opaque_tid(), wid = tid >> 6, lane = tid & 63, wr = wid >> 1, wc = wid & 1, fr = lane & 15, fq = lane >> 4;
    const int colw = pn * 128 + wc * 64, seg = colw >> 9, c0 = (colw & 511) + fq * 4;
    const bool samp = pm * 128 >= MP;
    const float* RSTD = (const float*)(p.ws + W_RSTD);
    unsigned char* ws = p.ws;
    float rsv[4];
#pragma unroll
    for (int m = 0; m < 4; ++m) rsv[m] = RSTD[pm * 128 + wr * 64 + m * 16 + fr];
    f32x4 gv[4];
    {
        const float* gsrc = seg == 0 ? p.qn_g + (c0 & 63) : seg == 1 ? p.kn_g + (c0 & 63) : seg >= 8 ? p.b_gate + (seg >= 10 ? 1024 : 0) + colw - (seg >= 10 ? 5120 : 4096) + fq * 4 : p.qn_g;
#pragma unroll
        for (int n = 0; n < 4; ++n) gv[n] = *(const f32x4*)(gsrc + n * 16);
    }
    __builtin_amdgcn_sched_barrier(0);
    __syncthreads();
    LAS unsigned char* NT = lds; LAS unsigned char* TT = lds + 34816;
#pragma unroll
    for (int m = 0; m < 4; ++m) {
        const int r = pm * 128 + wr * 64 + m * 16 + fr;
        const int lrow = wr * 64 + m * 16 + fr, lcol = wc * 64 + fq * 4;
        const float rs = rsv[m];
        f32x4 v[4];
#pragma unroll
        for (int n = 0; n < 4; ++n) v[n] = acc[m][n] * rs;
        const int rl = samp ? r - MP : r;
        const int tb = samp ? (rl >> 6) : (rl >> 11), tt = samp ? (rl & 63) : (rl & 2047), tstr = samp ? 64 : 2048;
        const size_t tbase = (samp ? TSAMP : 0) + (size_t)tb * 4 * 128 * tstr + tt;
        if (seg <= 1) {
            float ss = 0.f;
#pragma unroll
            for (int n = 0; n < 4; ++n) ss += v[n][0] * v[n][0] + v[n][1] * v[n][1] + v[n][2] * v[n][2] + v[n][3] * v[n][3];
            ss += __shfl_xor(ss, 16); ss += __shfl_xor(ss, 32);
            const float inv = rsqrtf(ss * (1.0f / 64.0f) + EPS);
            const float sc = seg == 0 ? inv * (0.125f * LOG2E) : inv;
            float* dstf = p.out + (samp ? O_KS + (size_t)rl * 512 : O_KP + (size_t)rl * 512);
#pragma unroll
            for (int n = 0; n < 4; ++n) {
                const int c = c0 + n * 16; const f32x4 g = gv[n];
                f32x4 o; o[0] = v[n][0] * sc * g[0]; o[1] = v[n][1] * sc * g[1]; o[2] = v[n][2] * sc * g[2]; o[3] = v[n][3] * sc * g[3];
                u32x2 w; w.x = cvt_pk_bf16(o[0], o[1]); w.y = cvt_pk_bf16(o[2], o[3]);
                *(LAS u32x2*)(NT + lrow * 272 + (lcol + n * 16) * 2) = w;
                if (seg == 1) *(f32x4*)(dstf + c) = o;
            }
        } else if (seg == 2 || seg == 6) {
            float* dstf = p.out + (samp ? O_VS + (size_t)rl * 512 : O_VP + (size_t)rl * 512);
#pragma unroll
            for (int n = 0; n < 4; ++n) {
                const int c = c0 + n * 16;
                if (seg == 2) *(f32x4*)(dstf + c) = v[n];
#pragma unroll
                for (int j = 0; j < 4; ++j) *(LAS bf16_t*)(TT + (lcol + n * 16 + j) * 272 + lrow * 2) = f2bf(v[n][j]);
            }
        } else if (seg == 3 || seg == 7) {
#pragma unroll
            for (int n = 0; n < 4; ++n) {
                const int c = c0 + n * 16; f32x4 o;
#pragma unroll
                for (int j = 0; j < 4; ++j) o[j] = v[n][j] * sigmoidf_(v[n][j]);
                u32x2 w; w.x = cvt_pk_bf16(o[0], o[1]); w.y = cvt_pk_bf16(o[2], o[3]);
                *(LAS u32x2*)(NT + lrow * 272 + (lcol + n * 16) * 2) = w;
            }
        } else if (seg == 4) {
#pragma unroll
            for (int n = 0; n < 4; ++n) { u32x2 w; w.x = cvt_pk_bf16(v[n][0], v[n][1]); w.y = cvt_pk_bf16(v[n][2], v[n][3]); *(LAS u32x2*)(NT + lrow * 272 + (lcol + n * 16) * 2) = w; }
        } else if (seg == 5) {
            const int hh = c0 >> 7;
            const float zeta = fexp2((float)(63 - (r & 63)) * log2_gamma(hh));
            const float ksc = 0.08838834764831845f;
#pragma unroll
            for (int n = 0; n < 4; ++n) {
                const int c = c0 + n * 16; f32x4 o = v[n] * ksc;
                u32x2 w; w.x = cvt_pk_bf16(o[0], o[1]); w.y = cvt_pk_bf16(o[2], o[3]); *(LAS u32x2*)(NT + lrow * 272 + (lcol + n * 16) * 2) = w;
#pragma unroll
                for (int j = 0; j < 4; ++j) *(LAS bf16_t*)(TT + (lcol + n * 16 + j) * 272 + lrow * 2) = f2bf(o[j] * zeta);
            }
        } else {
#pragma unroll
            for (int n = 0; n < 4; ++n) {
                const f32x4 b = gv[n]; f32x4 o;
#pragma unroll
                for (int j = 0; j < 4; ++j) o[j] = sigmoidf_(v[n][j] + b[j]);
                u32x2 w; w.x = cvt_pk_bf16(o[0], o[1]); w.y = cvt_pk_bf16(o[2], o[3]); *(LAS u32x2*)(NT + lrow * 272 + (lcol + n * 16) * 2) = w;
            }
        }
    }
    __syncthreads();
    const int rl0 = pm * 128 - (samp ? MP : 0), ct = (pn * 128) & 511;
    if (seg != 2 && seg != 6) {
        bf16_t* dst; int ld;
        if (seg < 8) { const size_t wo = seg == 0 ? W_QA : seg == 1 ? W_KA : seg == 3 ? W_SZA : seg == 4 ? W_QB : seg == 5 ? W_KB : W_SZB; dst = (bf16_t*)(ws + wo) + (size_t)(pm * 128) * 512 + ct; ld = 512; }
        else { const int which = seg >= 10, cg = pn * 128 - (which ? 5120 : 4096);
               dst = (samp ? (bf16_t*)(ws + (which ? W_GBS : W_GAS)) : (bf16_t*)p.out + (which ? (size_t)MP * 1024 : 0)) + (size_t)rl0 * 1024 + cg; ld = 1024; }
        u32x4 tv[8];
#pragma unroll
        for (int i = 0; i < 8; ++i) { const int q = tid + 256 * i; tv[i] = *(const LAS u32x4*)(NT + (q >> 4) * 272 + (q & 15) * 16); }
#pragma unroll
        for (int i = 0; i < 8; ++i) { const int q = tid + 256 * i; *(u32x4*)(dst + (size_t)(q >> 4) * ld + (q & 15) * 8) = tv[i]; }
    }
    if (seg == 2 || seg == 5 || seg == 6) {
        bf16_t* dstt = (bf16_t*)(ws + (seg == 2 ? W_VAT : seg == 5 ? W_KBT : W_VBT));
        const int tstr = samp ? 64 : 2048;
        u32x4 tv[8];
#pragma unroll
        for (int i = 0; i < 8; ++i) { const int q = tid + 256 * i; tv[i] = *(const LAS u32x4*)(TT + (q >> 4) * 272 + (q & 15) * 16); }
#pragma unroll
        for (int i = 0; i < 8; ++i) {
            const int q = tid + 256 * i, cl = q >> 4, rl = rl0 + (q & 15) * 8;
            const size_t tb = samp ? TSAMP + (size_t)(rl >> 6) * 4 * 128 * 64 + (rl & 63) : (size_t)(rl >> 11) * 4 * 128 * 2048 + (rl & 2047);
            *(u32x4*)(dstt + tb + (size_t)(ct + cl) * tstr) = tv[i];
        }
    }
}

__device__ void phase1(const Params& p, LAS unsigned char* lds) {
    const bf16_t* XN = (const bf16_t*)(p.ws + W_XN); const bf16_t* WT = (const bf16_t*)(p.ws + W_WINT);
    constexpr int NSM = 17, NSN = 6, NSUP = NSM * NSN, NSLOT = ((NSUP + 7) / 8) * 8 * 64;
    for (int tile = blockIdx.x; tile < NSLOT; tile += gridDim.x) {
        const int xcd = tile & 7, q = tile >> 3, S = (q >> 6) * 8 + xcd, within = q & 63;
        if (S >= NSUP) continue;
        const int pm = (S % NSM) * 8 + (within & 7), pn = (S / NSM) * 8 + (within >> 3);
        if (pm >= 132) continue;
        f32x4 acc[4][4]; acc_zero(acc);
        gemm_accum(acc, XN + (size_t)pm * 128 * DM, DM, WT + (size_t)pn * 128 * DM, DM, DM, lds);
        epi_inproj(p, acc, pm, pn, lds);
    }
}

template <bool WT>
__device__ __forceinline__ void p3a_tile(const Params& p, LAS unsigned char* lds, int pm, int pn) {
    const int tid = opaque_tid(), wid = tid >> 6, lane = tid & 63, wr = wid >> 1, wc = wid & 1, fr = lane & 15, fq = lane >> 4;
    const bf16_t* OAN = (const bf16_t*)(p.ws + W_OAN); const bf16_t* OBN = (const bf16_t*)(p.ws + W_OBN);
    const bf16_t* WA = (const bf16_t*)(p.ws + W_WOAT); const bf16_t* WB = (const bf16_t*)(p.ws + W_WOBT);
    bf16_t* MB = (bf16_t*)(p.ws + W_MB);
    const bool samp = pm * 128 >= MP;
    f32x4 acc[4][4]; acc_zero(acc);
    gemm_accum(acc, OAN + (size_t)pm * 128 * 512, 512, WA + (size_t)pn * 128 * 512, 512, 512, lds);
    const int cbase = pn * 128 + wc * 64 + fq * 4;
#pragma unroll
    for (int m = 0; m < 4; ++m) {
        const int r = pm * 128 + wr * 64 + m * 16 + fr, rl = samp ? r - MP : r;
        const bf16_t* ga = samp ? (const bf16_t*)(p.ws + W_GAS) + (size_t)rl * 1024 : (const bf16_t*)p.out + (size_t)rl * 1024;
        const bf16_t* gb = samp ? (const bf16_t*)(p.ws + W_GBS) + (size_t)rl * 1024 : (const bf16_t*)p.out + (size_t)MP * 1024 + (size_t)rl * 1024;
        u32x2 av[4], bv[4];
#pragma unroll
        for (int n = 0; n < 4; ++n) { av[n] = *(const u32x2*)(ga + cbase + n * 16); bv[n] = *(const u32x2*)(gb + cbase + n * 16); }
        __builtin_amdgcn_sched_barrier(0);
#pragma unroll
        for (int n = 0; n < 4; ++n) {
            const u32x2 a = av[n], b = bv[n];
            acc[m][n][0] *= bflo(a.x) * frcp(bflo(b.x)); acc[m][n][1] *= bfhi(a.x) * frcp(bfhi(b.x)); acc[m][n][2] *= bflo(a.y) * frcp(bflo(b.y)); acc[m][n][3] *= bfhi(a.y) * frcp(bfhi(b.y));
        }
    }
    gemm_accum(acc, OBN + (size_t)pm * 128 * 512, 512, WB + (size_t)pn * 128 * 512, 512, 512, lds);
#pragma unroll
    for (int m = 0; m < 4; ++m) {
        const int r = pm * 128 + wr * 64 + m * 16 + fr, rl = samp ? r - MP : r;
        const bf16_t* gb = samp ? (const bf16_t*)(p.ws + W_GBS) + (size_t)rl * 1024 : (const bf16_t*)p.out + (size_t)MP * 1024 + (size_t)rl * 1024;
        u32x2 bv[4];
#pragma unroll
        for (int n = 0; n < 4; ++n) bv[n] = *(const u32x2*)(gb + cbase + n * 16);
        __builtin_amdgcn_sched_barrier(0);
#pragma unroll
        for (int n = 0; n < 4; ++n) {
            const u32x2 b = bv[n];
            u32x2 w; w.x = cvt_pk_bf16(acc[m][n][0] * bflo(b.x), acc[m][n][1] * bfhi(b.x)); w.y = cvt_pk_bf16(acc[m][n][2] * bflo(b.y), acc[m][n][3] * bfhi(b.y));
            if constexpr (WT) __hip_atomic_store((unsigned long long*)(MB + (size_t)r * 1024 + cbase + n * 16), ((unsigned long long)w.y << 32) | w.x, __ATOMIC_RELAXED, __HIP_MEMORY_SCOPE_AGENT);
            else *(u32x2*)(MB + (size_t)r * 1024 + cbase + n * 16) = w;
        }
    }
}
__device__ __forceinline__ void p3b_tile(const Params& p, LAS unsigned char* lds, int pm, int pn) {
    const int tid = opaque_tid(), wid = tid >> 6, lane = tid & 63, wr = wid >> 1, wc = wid & 1, fr = lane & 15, fq = lane >> 4;
    const bf16_t* MB = (const bf16_t*)(p.ws + W_MB); const bf16_t* WO = (const bf16_t*)(p.ws + W_WOUTT);
    const bool samp = pm * 128 >= MP;
    f32x4 acc[4][4]; acc_zero(acc);
    gemm_accum(acc, MB + (size_t)pm * 128 * 1024, 1024, WO + (size_t)pn * 128 * 1024, 1024, 1024, lds);
    const int cbase = pn * 128 + wc * 64 + fq * 4;
#pragma unroll
    for (int m = 0; m < 4; ++m) {
        const int r = pm * 128 + wr * 64 + m * 16 + fr, rl = samp ? r - MP : r;
        const float* xr = (samp ? p.x_sample : p.x_prompt) + (size_t)rl * 1024;
        float* yr = p.out + (samp ? O_YS : O_YP) + (size_t)rl * 1024;
        f32x4 xv[4];
#pragma unroll
        for (int n = 0; n < 4; ++n) xv[n] = *(const f32x4*)(xr + cbase + n * 16);
        __builtin_amdgcn_sched_barrier(0);
#pragma unroll
        for (int n = 0; n < 4; ++n) *(f32x4*)(yr + cbase + n * 16) = xv[n] + acc[m][n];
    }
}
__device__ void phase3a(const Params& p, LAS unsigned char* lds) {
    constexpr int NSUP = 32, NSLOT = NSUP * 32;
    for (int tile = blockIdx.x; tile < NSLOT; tile += gridDim.x) {
        const int xcd = tile & 7, q = tile >> 3, S = (q >> 5) * 8 + xcd, within = q & 31;
        p3a_tile<false>(p, lds, S * 4 + (within & 3), within >> 2);
    }
}
__device__ void phase3b(const Params& p, LAS unsigned char* lds) {
    constexpr int NSUP = 32, NSLOT = NSUP * 32;
    for (int tile = blockIdx.x; tile < NSLOT; tile += gridDim.x) {
        const int xcd = tile & 7, q = tile >> 3, S = (q >> 5) * 8 + xcd, within = q & 31;
        p3b_tile(p, lds, S * 4 + (within & 3), within >> 2);
    }
}

constexpr int KS_STR = 272, VT_STR = 144, OX_STR = 132;
__device__ __forceinline__ void attn_finalize(const float* O, const float* L, int nsplit, int sstrO, int sstrL, int ostr, float lam, const float* __restrict__ gain, float gscale,
                                              const bf16_t* __restrict__ sz, bf16_t* __restrict__ dst, int row0, int h) {
    const int tid = opaque_tid(), t = tid >> 2, q = tid & 3;
    float l0 = 0.f, l1 = 0.f; f32x4 a0[8], a1[8];
#pragma unroll
    for (int i = 0; i < 8; ++i) { a0[i] = (f32x4){0.f, 0.f, 0.f, 0.f}; a1[i] = (f32x4){0.f, 0.f, 0.f, 0.f}; }
    for (int s = 0; s < nsplit; ++s) {
        l0 += L[s * sstrL + t]; l1 += L[s * sstrL + 64 + t];
        const float* o0 = O + (size_t)s * sstrO + t * ostr + q * 32; const float* o1 = o0 + 64 * ostr;
        f32x4 t0[8], t1[8];
#pragma unroll
        for (int i = 0; i < 8; ++i) { t0[i] = *(const f32x4*)(o0 + 4 * i); t1[i] = *(const f32x4*)(o1 + 4 * i); }
        __builtin_amdgcn_sched_barrier(0);
#pragma unroll
        for (int i = 0; i < 8; ++i) { a0[i] += t0[i]; a1[i] += t1[i]; }
    }
    const float c0 = 1.0f / l0, c1 = lam / l1; float ss = 0.f;
#pragma unroll
    for (int i = 0; i < 8; ++i) { a0[i] = a0[i] * c0 - a1[i] * c1; ss += a0[i][0] * a0[i][0] + a0[i][1] * a0[i][1] + a0[i][2] * a0[i][2] + a0[i][3] * a0[i][3]; }
    ss += __shfl_xor(ss, 1); ss += __shfl_xor(ss, 2);
    const float inv = rsqrtf(ss * (1.0f / 128.0f) + EPS) * gscale;
    const size_t base = (size_t)(row0 + t) * 512 + h * 128 + q * 32;
    u32x4 zz[4]; f32x4 gg[8];
#pragma unroll
    for (int i = 0; i < 4; ++i) { zz[i] = *(const u32x4*)(sz + base + 8 * i); gg[2 * i] = *(const f32x4*)(gain + q * 32 + 8 * i); gg[2 * i + 1] = *(const f32x4*)(gain + q * 32 + 8 * i + 4); }
    __builtin_amdgcn_sched_barrier(0);
#pragma unroll
    for (int i = 0; i < 4; ++i) {
        const u32x4 z = zz[i];
        const f32x4 g0 = gg[2 * i], g1 = gg[2 * i + 1];
        const f32x4 x0 = a0[2 * i], x1 = a0[2 * i + 1]; u32x4 w;
        w.x = cvt_pk_bf16(x0[0] * inv * g0[0] * bflo(z.x), x0[1] * inv * g0[1] * bfhi(z.x));
        w.y = cvt_pk_bf16(x0[2] * inv * g0[2] * bflo(z.y), x0[3] * inv * g0[3] * bfhi(z.y));
        w.z = cvt_pk_bf16(x1[0] * inv * g1[0] * bflo(z.z), x1[1] * inv * g1[1] * bfhi(z.z));
        w.w = cvt_pk_bf16(x1[2] * inv * g1[2] * bflo(z.w), x1[3] * inv * g1[3] * bfhi(z.w));
        *(u32x4*)(dst + base + 8 * i) = w;
    }
}

__device__ __forceinline__ void attn_item(const Params& p, LAS unsigned char* lds, bool samp, int b, int h, int idx) {
    const int tid = opaque_tid(), wid = tid >> 6, lane = tid & 63, r = lane & 31, hh = lane >> 5, qh = wid & 1, c = wid >> 1;
    const bf16_t* QA = (const bf16_t*)(p.ws + W_QA); const bf16_t* KA = (const bf16_t*)(p.ws + W_KA); const bf16_t* VAT = (const bf16_t*)(p.ws + W_VAT);
    const float* scal = (const float*)(p.ws + W_CTR);
    const float lam = scal[40], C2 = scal[41];
    int qrow0, qpos0, j0, j1;
    if (!samp) { qrow0 = b * 2048 + 64 * idx; qpos0 = 64 * idx; const int Tp = (111 << (2 * h + 2)) + 63; j0 = qpos0 >= Tp ? ((qpos0 - Tp) >> 6) + 1 : 0; j1 = idx + 1; }
    else {
        const int Th = (111 << (2 * h + 2)) + 63;
        const int jmin = PAST >= Th ? ((PAST - Th) >> 6) + 1 : 0, nt = 65 - jmin;
        const int nsh = nsplit_of(h);
        qrow0 = MP + b * 64; qpos0 = PAST; j0 = jmin + idx * nt / nsh; j1 = jmin + (idx + 1) * nt / nsh;
    }
    bf16x8 qf[4];
    { const bf16_t* qp = QA + (size_t)(qrow0 + 32 * qh + r) * 512 + h * 128 + c * 64 + 8 * hh;
#pragma unroll
      for (int kk = 0; kk < 4; ++kk) qf[kk] = *(const bf16x8*)(qp + 16 * kk); }
    const float sl2 = exp2f(-2.0f * (float)(h + 1)) * LOG2E;
    const float qposf = (float)(qpos0 + 32 * qh + r);
    f32x16 O[4];
#pragma unroll
    for (int dt = 0; dt < 4; ++dt)
#pragma unroll
        for (int g = 0; g < 16; ++g) O[dt][g] = 0.f;
    float lsum = 0.f;
    LAS unsigned char* Ks = lds; LAS unsigned char* Vt = lds + 17408;
    const int pr = pi32(r);
    u32x4 stg[16];
    const int tid_ = tid;
    auto issue = [&](int j) {
        int tid = tid_; asm volatile("" : "+v"(tid));
        if (samp && j < 64) {
            const float* kc = p.cache_k + (((size_t)b * PAST + 64 * j) * 4 + h) * 128;
            const float* vc = p.cache_v + (((size_t)b * PAST + 64 * j) * 4 + h) * 128;
            const int kg = tid >> 5, piece = tid & 31;
#pragma unroll
            for (int i = 0; i < 8; ++i) stg[i] = *(const u32x4*)(kc + (size_t)(kg + 8 * i) * 512 + piece * 4);
#pragma unroll
            for (int i = 0; i < 8; ++i) stg[8 + i] = *(const u32x4*)(vc + (size_t)(8 * kg + i) * 512 + piece * 4);
        } else {
            const int krow0 = samp ? MP + b * 64 : b * 2048 + 64 * j;
            const bf16_t* kp = KA + (size_t)krow0 * 512 + h * 128;
            const bf16_t* vp = samp ? VAT + TSAMP + (size_t)(b * 4 + h) * 128 * 64 : VAT + (size_t)(b * 4 + h) * 128 * 2048 + 64 * j;
            const int vstr = samp ? 64 : 2048;
#pragma unroll
            for (int i = 0; i < 4; ++i) stg[i] = *(const u32x4*)(kp + (size_t)((tid >> 4) + 16 * i) * 512 + (tid & 15) * 8);
#pragma unroll
            for (int i = 0; i < 4; ++i) stg[4 + i] = *(const u32x4*)(vp + (size_t)((tid >> 3) + 32 * i) * vstr + (tid & 7) * 8);
        }
    };
    auto commit = [&](int j, LAS unsigned char* Kd, LAS unsigned char* Vd) {
        int tid = tid_; asm volatile("" : "+v"(tid));
        if (samp && j < 64) {
            const int kg = tid >> 5, piece = tid & 31;
#pragma unroll
            for (int i = 0; i < 8; ++i) { u32x2 w; w.x = cvt_pk_bf16(__uint_as_float(stg[i].x), __uint_as_float(stg[i].y)); w.y = cvt_pk_bf16(__uint_as_float(stg[i].z), __uint_as_float(stg[i].w)); *(LAS u32x2*)(Kd + (kg + 8 * i) * KS_STR + piece * 8) = w; }
            { u32x4 w; w.x = cvt_pk_bf16(__uint_as_float(stg[8].x), __uint_as_float(stg[9].x)); w.y = cvt_pk_bf16(__uint_as_float(stg[10].x), __uint_as_float(stg[11].x)); w.z = cvt_pk_bf16(__uint_as_float(stg[12].x), __uint_as_float(stg[13].x)); w.w = cvt_pk_bf16(__uint_as_float(stg[14].x), __uint_as_float(stg[15].x)); *(LAS u32x4*)(Vd + (4 * piece + 0) * VT_STR + kg * 16) = w; }
            { u32x4 w; w.x = cvt_pk_bf16(__uint_as_float(stg[8].y), __uint_as_float(stg[9].y)); w.y = cvt_pk_bf16(__uint_as_float(stg[10].y), __uint_as_float(stg[11].y)); w.z = cvt_pk_bf16(__uint_as_float(stg[12].y), __uint_as_float(stg[13].y)); w.w = cvt_pk_bf16(__uint_as_float(stg[14].y), __uint_as_float(stg[15].y)); *(LAS u32x4*)(Vd + (4 * piece + 1) * VT_STR + kg * 16) = w; }
            { u32x4 w; w.x = cvt_pk_bf16(__uint_as_float(stg[8].z), __uint_as_float(stg[9].z)); w.y = cvt_pk_bf16(__uint_as_float(stg[10].z), __uint_as_float(stg[11].z)); w.z = cvt_pk_bf16(__uint_as_float(stg[12].z), __uint_as_float(stg[13].z)); w.w = cvt_pk_bf16(__uint_as_float(stg[14].z), __uint_as_float(stg[15].z)); *(LAS u32x4*)(Vd + (4 * piece + 2) * VT_STR + kg * 16) = w; }
            { u32x4 w; w.x = cvt_pk_bf16(__uint_as_float(stg[8].w), __uint_as_float(stg[9].w)); w.y = cvt_pk_bf16(__uint_as_float(stg[10].w), __uint_as_float(stg[11].w)); w.z = cvt_pk_bf16(__uint_as_float(stg[12].w), __uint_as_float(stg[13].w)); w.w = cvt_pk_bf16(__uint_as_float(stg[14].w), __uint_as_float(stg[15].w)); *(LAS u32x4*)(Vd + (4 * piece + 3) * VT_STR + kg * 16) = w; }
        } else {
#pragma unroll
            for (int i = 0; i < 4; ++i) *(LAS u32x4*)(Kd + ((tid >> 4) + 16 * i) * KS_STR + (tid & 15) * 16) = stg[i];
#pragma unroll
            for (int i = 0; i < 4; ++i) *(LAS u32x4*)(Vd + ((tid >> 3) + 32 * i) * VT_STR + (tid & 7) * 16) = stg[4 + i];
        }
    };
    issue(j0);
    __syncthreads();
    commit(j0, Ks, Vt);
    __syncthreads();
    for (int j = j0; j < j1; ++j) {
        const int cur = (j - j0) & 1;
        const LAS unsigned char* Kc = Ks + cur * 35840; const LAS unsigned char* Vc = Vt + cur * 35840;
        if (j + 1 < j1) issue(j + 1);
        __builtin_amdgcn_sched_barrier(0);
#pragma unroll
        for (int si = 0; si < 2; ++si) {
            f32x16 s;
#pragma unroll
            for (int g = 0; g < 16; ++g) s[g] = 0.f;
#pragma unroll
            for (int kk = 0; kk < 4; ++kk) { const bf16x8 kf = lds_rd16(Kc + (32 * si + pr) * KS_STR + (c * 64 + 16 * kk + 8 * hh) * 2); s = mfma32(kf, qf[kk], s); }
#pragma unroll
            for (int g = 0; g < 16; ++g) {
                const float kposf = (float)(64 * j + 32 * si + prow(g, hh));
                const float e = fexp2(s[g] - sl2 * fabsf(qposf - kposf) - C2);
                lsum += e; s[g] = e;
            }
#pragma unroll
            for (int st = 0; st < 2; ++st) {
                const bf16x8 pb = pack8(s, st);
#pragma unroll
                for (int dt = 0; dt < 4; ++dt) { const bf16x8 vf = lds_rd16(Vc + (32 * dt + r) * VT_STR + (32 * si + 16 * st + 8 * hh) * 2); O[dt] = mfma32(vf, pb, O[dt]); }
            }
        }
        __builtin_amdgcn_sched_barrier(0);
        if (j + 1 < j1) commit(j + 1, Ks + (cur ^ 1) * 35840, Vt + (cur ^ 1) * 35840);
        __syncthreads();
    }
    lsum += __shfl_xor(lsum, 32);
    __syncthreads();
    const bf16_t* SZA = (const bf16_t*)(p.ws + W_SZA); bf16_t* OAN = (bf16_t*)(p.ws + W_OAN);
    if (!samp) {
        LAS float* OX = (LAS float*)lds; LAS float* LX = (LAS float*)(lds + 67584);
#pragma unroll
        for (int dt = 0; dt < 4; ++dt)
#pragma unroll
            for (int g4 = 0; g4 < 4; ++g4)
                *(LAS f32x4*)(OX + (c * 64 + 32 * qh + r) * OX_STR + 32 * dt + 8 * g4 + 4 * hh) = (f32x4){O[dt][4 * g4], O[dt][4 * g4 + 1], O[dt][4 * g4 + 2], O[dt][4 * g4 + 3]};
        if (hh == 0) LX[c * 64 + 32 * qh + r] = lsum;
        __syncthreads();
        attn_finalize((const float*)OX, (const float*)LX, 1, 0, 0, OX_STR, lam, p.subln_g, 0.8f, SZA, OAN, qrow0, h);
    } else {
        const int bh = b * 4 + h;
        const int slot0 = b * 4 * NSPLIT + slot_of(h), nsh = nsplit_of(h);
        float* PO = (float*)(p.ws + W_PO) + (size_t)slot0 * 2 * 64 * 128; float* PL = (float*)(p.ws + W_PL) + (size_t)slot0 * 128;
        float* po = PO + (size_t)idx * 2 * 64 * 128; float* pl = PL + idx * 128;
#pragma unroll
        for (int dt = 0; dt < 4; ++dt)
#pragma unroll
            for (int g4 = 0; g4 < 4; ++g4)
            {
                unsigned long long* q8 = (unsigned long long*)(po + (c * 64 + 32 * qh + r) * 128 + 32 * dt + 8 * g4 + 4 * hh);
                __hip_atomic_store(q8, ((unsigned long long)__float_as_uint(O[dt][4 * g4 + 1]) << 32) | __float_as_uint(O[dt][4 * g4]), __ATOMIC_RELAXED, __HIP_MEMORY_SCOPE_AGENT);
                __hip_atomic_store(q8 + 1, ((unsigned long long)__float_as_uint(O[dt][4 * g4 + 3]) << 32) | __float_as_uint(O[dt][4 * g4 + 2]), __ATOMIC_RELAXED, __HIP_MEMORY_SCOPE_AGENT);
            }
        if (hh == 0) __hip_atomic_store((unsigned*)(pl + c * 64 + 32 * qh + r), __float_as_uint(lsum), __ATOMIC_RELAXED, __HIP_MEMORY_SCOPE_AGENT);
        asm volatile("s_waitcnt vmcnt(0)" ::: "memory");
        __syncthreads();
        if (tid == 0) {
            const unsigned old = __hip_atomic_fetch_add((unsigned*)(p.ws + W_CTR) + bh, 1u, __ATOMIC_RELAXED, __HIP_MEMORY_SCOPE_AGENT);
            const unsigned last = (old == (unsigned)(nsh - 1)) ? 1u : 0u;
            if (last) { __builtin_amdgcn_fence(__ATOMIC_ACQUIRE, "agent"); asm volatile("s_waitcnt vmcnt(0)" ::: "memory"); }
            *(LAS unsigned*)(lds + SM_FLAG + 4) = last;
        }
        __syncthreads();
        if (*(LAS unsigned*)(lds + SM_FLAG + 4)) {
            attn_finalize(PO, PL, nsh, 2 * 64 * 128, 128, 128, lam, p.subln_g, 0.8f, SZA, OAN, qrow0, h);
        }
    }
}

__device__ __forceinline__ void ret_item(const Params& p, LAS unsigned char* lds, bool samp, int b, int h, int grp) {
    const int tid = opaque_tid(), wid = tid >> 6, lane = tid & 63, r = lane & 31, hh = lane >> 5, dvb = 32 * wid;
    LAS unsigned char* Qs = lds; LAS unsigned char* Ks = lds + 17408; LAS unsigned char* Kt = lds + 34816; LAS unsigned char* Vt = lds + 53248;
    const int pr = pi32(r);
    LAS float* Ost = (LAS float*)lds;
    const bf16_t* QB = (const bf16_t*)(p.ws + W_QB); const bf16_t* KB = (const bf16_t*)(p.ws + W_KB);
    const bf16_t* KBT = (const bf16_t*)(p.ws + W_KBT); const bf16_t* VBT = (const bf16_t*)(p.ws + W_VBT);
    const bf16_t* SZB = (const bf16_t*)(p.ws + W_SZB); bf16_t* OBN = (bf16_t*)(p.ws + W_OBN);
    const float lg0 = log2_gamma(h), g64 = fexp2(64.0f * lg0);
    const int bh = b * 4 + h;
    f32x16 R[4];
    if (samp) {
        const float* sr = p.state_ret + (size_t)bh * 128 * 128;
#pragma unroll
        for (int di = 0; di < 4; ++di)
#pragma unroll
            for (int g = 0; g < 16; ++g) R[di][g] = sr[(32 * di + prow(g, hh)) * 128 + dvb + r];
    } else {
#pragma unroll
        for (int di = 0; di < 4; ++di)
#pragma unroll
            for (int g = 0; g < 16; ++g) R[di][g] = 0.f;
    }
    const int n0 = samp ? 0 : GC * grp, n1 = samp ? 1 : GC * grp + GC, rowbase = samp ? MP + b * 64 : b * 2048, tstr = samp ? 64 : 2048;
    const size_t tbase = samp ? TSAMP + (size_t)bh * 128 * 64 : (size_t)bh * 128 * 2048;
    for (int n = n0; n < n1; ++n) {
        __syncthreads();
        {
            const bf16_t* qp = QB + (size_t)(rowbase + 64 * n) * 512 + h * 128; const bf16_t* kp = KB + (size_t)(rowbase + 64 * n) * 512 + h * 128;
            const bf16_t* ktp = KBT + tbase + 64 * n; const bf16_t* vtp = VBT + tbase + 64 * n;
            u32x4 wq[4], wk[4], wkt[4], wvt[4];
#pragma unroll
            for (int i = 0; i < 4; ++i) { wq[i] = *(const u32x4*)(qp + (size_t)((tid >> 4) + 16 * i) * 512 + (tid & 15) * 8); wk[i] = *(const u32x4*)(kp + (size_t)((tid >> 4) + 16 * i) * 512 + (tid & 15) * 8); }
#pragma unroll
            for (int i = 0; i < 4; ++i) { wkt[i] = *(const u32x4*)(ktp + (size_t)((tid >> 3) + 32 * i) * tstr + (tid & 7) * 8); wvt[i] = *(const u32x4*)(vtp + (size_t)((tid >> 3) + 32 * i) * tstr + (tid & 7) * 8); }
#pragma unroll
            for (int i = 0; i < 4; ++i) { *(LAS u32x4*)(Qs + ((tid >> 4) + 16 * i) * KS_STR + (tid & 15) * 16) = wq[i]; *(LAS u32x4*)(Ks + ((tid >> 4) + 16 * i) * KS_STR + (tid & 15) * 16) = wk[i]; }
#pragma unroll
            for (int i = 0; i < 4; ++i) { *(LAS u32x4*)(Kt + ((tid >> 3) + 32 * i) * VT_STR + (tid & 7) * 16) = wkt[i]; *(LAS u32x4*)(Vt + ((tid >> 3) + 32 * i) * VT_STR + (tid & 7) * 16) = wvt[i]; }
        }
        __syncthreads();
        float lg = lg0; int hv = hh, rv = r; asm volatile("" : "+v"(lg), "+v"(hv), "+v"(rv));
        const float xb = (float)(4 * hv + 1), db = (float)(rv - 8 * hv);
        f32x16 o[2];
#pragma unroll
        for (int ti = 0; ti < 2; ++ti) {
            f32x16 acc;
#pragma unroll
            for (int g = 0; g < 16; ++g) acc[g] = 0.f;
            bf16x8 qf[8];
#pragma unroll
            for (int kk = 0; kk < 8; ++kk) qf[kk] = lds_rd16(Qs + (32 * ti + r) * KS_STR + (16 * kk + 8 * hh) * 2);
#pragma unroll
            for (int di = 0; di < 4; ++di)
#pragma unroll
                for (int st = 0; st < 2; ++st) acc = mfma32(qf[2 * di + st], pack8(R[di], st), acc);
#pragma unroll
            for (int g = 0; g < 16; ++g) acc[g] *= fexp2((xb + (float)(32 * ti + (g & 3) + 8 * (g >> 2))) * lg);
            __builtin_amdgcn_sched_barrier(0);
#pragma unroll
            for (int si = 0; si < 2; ++si) {
                f32x16 s;
#pragma unroll
                for (int g = 0; g < 16; ++g) s[g] = 0.f;
#pragma unroll
                for (int kk = 0; kk < 8; ++kk) {
                    const bf16x8 kf = lds_rd16(Ks + (32 * si + pr) * KS_STR + (16 * kk + 8 * hh) * 2);
                    s = mfma32(kf, qf[kk], s);
                }
#pragma unroll
                for (int g = 0; g < 16; ++g) s[g] *= fexp2(fabsf(db + (float)(32 * ti - 32 * si - (g & 3) - 4 * ((g >> 2) & 1) - 16 * (g >> 3))) * lg);
#pragma unroll
                for (int st = 0; st < 2; ++st) {
                    const bf16x8 ap = pack8(s, st);
                    const bf16x8 vf = lds_rd16(Vt + (dvb + r) * VT_STR + (32 * si + 16 * st + 8 * hh) * 2);
                    acc = mfma32(ap, vf, acc);
                }
                __builtin_amdgcn_sched_barrier(0);
            }
            o[ti] = acc;
        }
#pragma unroll
        for (int di = 0; di < 4; ++di) {
#pragma unroll
            for (int g = 0; g < 16; ++g) R[di][g] *= g64;
#pragma unroll
            for (int kk = 0; kk < 4; ++kk) {
                const bf16x8 af = lds_rd16(Kt + (32 * di + pr) * VT_STR + (16 * kk + 8 * hh) * 2);
                const bf16x8 vf = lds_rd16(Vt + (dvb + r) * VT_STR + (16 * kk + 8 * hh) * 2);
                R[di] = mfma32(af, vf, R[di]);
            }
        }
        __syncthreads();
#pragma unroll
        for (int ti = 0; ti < 2; ++ti)
#pragma unroll
            for (int g = 0; g < 16; ++g) Ost[(32 * ti + accrow(g, hh)) * OX_STR + dvb + r] = o[ti][g];
        __syncthreads();
        if (!samp) {
            const int t = tid >> 2, q = tid & 3;
            float* op = (float*)(p.ws + W_OP) + (size_t)(rowbase + 64 * n + t) * 512 + h * 128 + q * 32;
#pragma unroll
            for (int i = 0; i < 8; ++i) *(f32x4*)(op + 4 * i) = *(const LAS f32x4*)(Ost + t * OX_STR + q * 32 + 4 * i);
        } else {
            const int t = tid >> 2, q = tid & 3; f32x4 a[8]; float ss = 0.f;
#pragma unroll
            for (int i = 0; i < 8; ++i) { a[i] = *(const LAS f32x4*)(Ost + t * OX_STR + q * 32 + 4 * i); ss += a[i][0] * a[i][0] + a[i][1] * a[i][1] + a[i][2] * a[i][2] + a[i][3] * a[i][3]; }
            ss += __shfl_xor(ss, 1); ss += __shfl_xor(ss, 2);
            const float inv = rsqrtf(ss * (1.0f / 128.0f) + EPS);
            const size_t base = (size_t)(rowbase + 64 * n + t) * 512 + h * 128 + q * 32;
            u32x4 zz[4];
#pragma unroll
            for (int i = 0; i < 4; ++i) zz[i] = *(const u32x4*)(SZB + base + 8 * i);
            __builtin_amdgcn_sched_barrier(0);
#pragma unroll
            for (int i = 0; i < 4; ++i) {
                const u32x4 z = zz[i]; const f32x4 x0 = a[2 * i], x1 = a[2 * i + 1]; u32x4 w;
                w.x = cvt_pk_bf16(x0[0] * inv * bflo(z.x), x0[1] * inv * bfhi(z.x)); w.y = cvt_pk_bf16(x0[2] * inv * bflo(z.y), x0[3] * inv * bfhi(z.y));
                w.z = cvt_pk_bf16(x1[0] * inv * bflo(z.z), x1[1] * inv * bfhi(z.z)); w.w = cvt_pk_bf16(x1[2] * inv * bflo(z.w), x1[3] * inv * bfhi(z.w));
                *(u32x4*)(OBN + base + 8 * i) = w;
            }
        }
    }
    float* ro = samp ? p.out + O_RS + (size_t)bh * 128 * 128 : (float*)(p.ws + W_UG) + (size_t)(bh * NG + grp) * 128 * 128;
#pragma unroll
    for (int di = 0; di < 4; ++di)
#pragma unroll
        for (int g = 0; g < 16; ++g) ro[(32 * di + prow(g, hh)) * 128 + dvb + r] = R[di][g];
}

__device__ __forceinline__ void ret_fix_item(const Params& p, LAS unsigned char* lds, int bh, int grp, int c) {
    const int tid = opaque_tid(), wid = tid >> 6, lane = tid & 63, r = lane & 31, hh = lane >> 5, dvb = 32 * wid;
    const int b = bh >> 2, h = bh & 3;
    LAS float* Ost = (LAS float*)lds;
    const bf16_t* QB = (const bf16_t*)(p.ws + W_QB); const bf16_t* SZB = (const bf16_t*)(p.ws + W_SZB); bf16_t* OBN = (bf16_t*)(p.ws + W_OBN);
    const float* UG = (const float*)(p.ws + W_UG) + (size_t)bh * NG * 16384;
    const float* OP = (const float*)(p.ws + W_OP);
    const float lg = log2_gamma(h), g256 = fexp2((float)(64 * GC) * lg);
    const int row0 = b * 2048 + 64 * (GC * grp + c);
    f32x16 o[2];
    if (grp > 0) {
        float R0[64];
#pragma unroll
        for (int i = 0; i < 64; ++i) R0[i] = 0.f;
        for (int gp = 0; gp < grp; gp += 2) {
            const bool two = gp + 1 < grp;
            const float* u0 = UG + (size_t)gp * 16384 + (8 * hh) * 128 + dvb + r;
            const float* u1 = UG + (size_t)(two ? gp + 1 : gp) * 16384 + (8 * hh) * 128 + dvb + r;
            const float w1 = two ? 1.0f : 0.0f, w0 = two ? g256 : 1.0f, wr0 = two ? g256 * g256 : g256;
#pragma unroll
            for (int hf = 0; hf < 2; ++hf) {
                float ta[32], tb[32];
#pragma unroll
                for (int i = 0; i < 32; ++i) { ta[i] = u0[(16 * ((32 * hf + i) >> 3) + (i & 7)) * 128]; tb[i] = u1[(16 * ((32 * hf + i) >> 3) + (i & 7)) * 128]; }
                __builtin_amdgcn_sched_barrier(0);
#pragma unroll
                for (int i = 0; i < 32; ++i) R0[32 * hf + i] = R0[32 * hf + i] * wr0 + ta[i] * w0 + tb[i] * w1;
                __builtin_amdgcn_sched_barrier(0);
            }
        }
        if (grp == NG - 1 && c == GC - 1) {
            const float* u = UG + (size_t)(NG - 1) * 16384 + (8 * hh) * 128 + dvb + r;
            float* ro = p.out + O_RP + (size_t)bh * 16384 + (8 * hh) * 128 + dvb + r;
#pragma unroll
            for (int hf = 0; hf < 2; ++hf) {
                float tu[32];
#pragma unroll
                for (int i = 0; i < 32; ++i) tu[i] = u[(16 * ((32 * hf + i) >> 3) + (i & 7)) * 128];
                __builtin_amdgcn_sched_barrier(0);
#pragma unroll
                for (int i = 0; i < 32; ++i) ro[(16 * ((32 * hf + i) >> 3) + (i & 7)) * 128] = R0[32 * hf + i] * g256 + tu[i];
                __builtin_amdgcn_sched_barrier(0);
            }
        }
        bf16x8 rf[8];
#pragma unroll
        for (int kk = 0; kk < 8; ++kk) {
            u32x4 w; w.x = cvt_pk_bf16(R0[8 * kk + 0], R0[8 * kk + 1]); w.y = cvt_pk_bf16(R0[8 * kk + 2], R0[8 * kk + 3]);
            w.z = cvt_pk_bf16(R0[8 * kk + 4], R0[8 * kk + 5]); w.w = cvt_pk_bf16(R0[8 * kk + 6], R0[8 * kk + 7]);
            rf[kk] = __builtin_bit_cast(bf16x8, w);
        }
#pragma unroll
        for (int ti = 0; ti < 2; ++ti) {
            f32x16 acc;
#pragma unroll
            for (int g = 0; g < 16; ++g) acc[g] = 0.f;
            const bf16_t* qp = QB + (size_t)(row0 + 32 * ti + r) * 512 + h * 128 + 8 * hh;
            bf16x8 qf[8];
#pragma unroll
            for (int kk = 0; kk < 8; ++kk) qf[kk] = *(const bf16x8*)(qp + 16 * kk);
            __builtin_amdgcn_sched_barrier(0);
#pragma unroll
            for (int kk = 0; kk < 8; ++kk) acc = mfma32(qf[kk], rf[kk], acc);
#pragma unroll
            for (int g = 0; g < 16; ++g) acc[g] *= fexp2((float)(64 * c + 32 * ti + accrow(g, hh) + 1) * lg);
            o[ti] = acc;
        }
    } else {
#pragma unroll
        for (int ti = 0; ti < 2; ++ti)
#pragma unroll
            for (int g = 0; g < 16; ++g) o[ti][g] = 0.f;
    }
    __syncthreads();
#pragma unroll
    for (int ti = 0; ti < 2; ++ti)
#pragma unroll
        for (int g = 0; g < 16; ++g) Ost[(32 * ti + accrow(g, hh)) * OX_STR + dvb + r] = o[ti][g];
    __syncthreads();
    {
        const int t = tid >> 2, q = tid & 3; f32x4 a[8]; float ss = 0.f;
        const float* op = OP + (size_t)(row0 + t) * 512 + h * 128 + q * 32;
        const size_t base = (size_t)(row0 + t) * 512 + h * 128 + q * 32;
        f32x4 po[8]; u32x4 zz[4];
#pragma unroll
        for (int i = 0; i < 8; ++i) po[i] = *(const f32x4*)(op + 4 * i);
#pragma unroll
        for (int i = 0; i < 4; ++i) zz[i] = *(const u32x4*)(SZB + base + 8 * i);
        __builtin_amdgcn_sched_barrier(0);
#pragma unroll
        for (int i = 0; i < 8; ++i) { a[i] = *(const LAS f32x4*)(Ost + t * OX_STR + q * 32 + 4 * i) + po[i]; ss += a[i][0] * a[i][0] + a[i][1] * a[i][1] + a[i][2] * a[i][2] + a[i][3] * a[i][3]; }
        ss += __shfl_xor(ss, 1); ss += __shfl_xor(ss, 2);
        const float inv = rsqrtf(ss * (1.0f / 128.0f) + EPS);
#pragma unroll
        for (int i = 0; i < 4; ++i) {
            const u32x4 z = zz[i]; const f32x4 x0 = a[2 * i], x1 = a[2 * i + 1]; u32x4 w;
            w.x = cvt_pk_bf16(x0[0] * inv * bflo(z.x), x0[1] * inv * bfhi(z.x)); w.y = cvt_pk_bf16(x0[2] * inv * bflo(z.y), x0[3] * inv * bfhi(z.y));
            w.z = cvt_pk_bf16(x1[0] * inv * bflo(z.z), x1[1] * inv * bfhi(z.z)); w.w = cvt_pk_bf16(x1[2] * inv * bflo(z.w), x1[3] * inv * bfhi(z.w));
            *(u32x4*)(OBN + base + 8 * i) = w;
        }
    }
}
__device__ void phase2b(const Params& p, LAS unsigned char* lds) {
    auto fix = [&](int it) { ret_fix_item(p, lds, it & 31, it < 512 ? (NG - 1) - ((it >> 5) & (NG - 1)) : ((it >> 5) & (NG - 1)), (it >> 7) & (GC - 1)); };
    if (blockIdx.x < 64) {
        const int sb = blockIdx.x & 31, pm = 128 + (sb >> 3), pn = sb & 7;
        unsigned* c3 = (unsigned*)(p.ws + W_CTR) + 56 + (sb >> 3);
        if (blockIdx.x < 32) {
            p3a_tile<true>(p, lds, pm, pn);
            asm volatile("s_waitcnt vmcnt(0)" ::: "memory");
            __syncthreads();
            if (threadIdx.x == 0) __hip_atomic_fetch_add(c3, 1u, __ATOMIC_RELAXED, __HIP_MEMORY_SCOPE_AGENT);
            fix(96 + sb);
        } else {
            fix(224 + sb);
            if (threadIdx.x == 0) {
                while (__hip_atomic_load(c3, __ATOMIC_RELAXED, __HIP_MEMORY_SCOPE_AGENT) < 8u) __builtin_amdgcn_s_sleep(2);
                __builtin_amdgcn_fence(__ATOMIC_ACQUIRE, "agent");
                asm volatile("s_waitcnt vmcnt(0)" ::: "memory");
            }
            __syncthreads();
            p3b_tile(p, lds, pm, pn);
        }
        return;
    }
    for (int it = blockIdx.x - 64; it < 1024; it += gridDim.x - 64) { if ((it & ~31) == 96 || (it & ~31) == 224) continue; fix(it); }
}

constexpr int NRET = 32 * NG + 32;
constexpr int NITEMS = NRET + 32 * NSPLIT + 1024;
__device__ void phase2(const Params& p, LAS unsigned char* lds) {
    unsigned* ctr = (unsigned*)(p.ws + W_CTR);
    for (;;) {
        __syncthreads();
        if (threadIdx.x == 0) *(LAS int*)(lds + SM_FLAG) = (int)atomicAdd(ctr + 32, 1u);
        __syncthreads();
        const int it = *(LAS int*)(lds + SM_FLAG);
        if (it >= NITEMS) break;
        if (it < NRET) { const bool samp = it >= 32 * NG; const int bh = samp ? it - 32 * NG : it / NG; ret_item(p, lds, samp, bh >> 2, bh & 3, it % NG); }
        else {
            bool samp; int bh, idx;
            if (it < NRET + 32 * NSPLIT) { samp = true; const int kk = it - NRET, bb = kk / 24, s = kk % 24, hs = s < 2 ? 0 : s < 6 ? 1 : s < 15 ? 2 : 3; bh = bb * 4 + hs; idx = s - slot_of(hs); }
            else { samp = false; const int k = it - NRET - 32 * NSPLIT; idx = 31 - (k >> 5); bh = k & 31; }
            attn_item(p, lds, samp, bh >> 2, bh & 3, idx);
        }
    }
}

#define XB_TMO      128
#define XB_XCNT(j)  (256  + 64 * (j))
#define XB_XSUB(j)  (1280 + 64 * (j))
#define XB_XGEN(j)  (2304 + 64 * (j))
#define XB_TOP      3328
#define XB_TOPGEN   3392
#define XCD_BAR_WORDS 3456
#define XB_SPIN_CAP (1u << 18)

__device__ __forceinline__ unsigned xb_ld(unsigned* p)              { return __hip_atomic_load(p, __ATOMIC_RELAXED, __HIP_MEMORY_SCOPE_AGENT); }
__device__ __forceinline__ unsigned xb_add(unsigned* p, unsigned v) { return __hip_atomic_fetch_add(p, v, __ATOMIC_RELAXED, __HIP_MEMORY_SCOPE_AGENT); }
__device__ __forceinline__ unsigned xb_xcc_id() { return (unsigned)__builtin_amdgcn_s_getreg((3 << 11) | 20) & 0xFu; }
#define XB_SPIN(cond, bar) do { unsigned _sp = 0; while (cond) { __builtin_amdgcn_s_sleep(1); \
    if ((++_sp & 255u) == 0u) { if (xb_ld(&(bar)[XB_TMO])) break; if (_sp > XB_SPIN_CAP) { atomicAdd(&(bar)[XB_TMO], 1u); break; } } } } while (0)

struct XcdBarrier {
    unsigned* bar; unsigned x;
    volatile LAS unsigned* st;
};

__device__ __forceinline__ XcdBarrier xcd_barrier_post(unsigned* bar, volatile LAS unsigned* st) {
    XcdBarrier b; b.bar = bar; b.x = xb_xcc_id(); b.st = st;
    if (threadIdx.x == 0) (void)xb_add(&bar[XB_XCNT(b.x)], 1u);
    return b;
}
__device__ __forceinline__ void xcd_barrier_complete(unsigned* bar, unsigned x, unsigned& nloc, unsigned& nx) {
    const unsigned G = gridDim.x * gridDim.y * gridDim.z;
    unsigned sum, cnt, mine, sp = 0u;
    for (;;) {
        sum = 0u; cnt = 0u; mine = 0u;
#pragma unroll
        for (unsigned j = 0; j < 16; ++j) { const unsigned c = xb_ld(&bar[XB_XCNT(j)]); sum += c; cnt += (c > 0u) ? 1u : 0u; mine = (j == x) ? c : mine; }
        if (sum == G) break;
        __builtin_amdgcn_s_sleep(1);
        if ((++sp & 255u) == 0u) { if (xb_ld(&bar[XB_TMO])) break; if (sp > XB_SPIN_CAP) { atomicAdd(&bar[XB_TMO], 1u); break; } }
    }
    nloc = mine > 0u ? mine : 1u; nx = cnt > 0u ? cnt : 1u;
}

__device__ __forceinline__ void xcd_barrier(const XcdBarrier& b) {
    asm volatile("s_waitcnt vmcnt(0)" ::: "memory");
    __syncthreads();
    if (threadIdx.x == 0) {
        unsigned* bar = b.bar;
        __builtin_amdgcn_s_waitcnt(0);
        unsigned nloc = b.st[0], nx = b.st[1];
        if (nloc == 0u) { xcd_barrier_complete(bar, b.x, nloc, nx); b.st[0] = nloc; b.st[1] = nx; }
        const unsigned old = xb_add(&bar[XB_XSUB(b.x)], 1u);
        const unsigned gen = old / nloc;
        if (old + 1u == (gen + 1u) * nloc) {
            __builtin_amdgcn_fence(__ATOMIC_RELEASE, "agent");
            asm volatile("s_waitcnt vmcnt(0)" ::: "memory");
            const unsigned og = xb_add(&bar[XB_TOP], 1u);
            const unsigned tg = og / nx;
            if (og + 1u == (tg + 1u) * nx) xb_add(&bar[XB_TOPGEN], 1u);
            else XB_SPIN(xb_ld(&bar[XB_TOPGEN]) == tg, bar);
            __builtin_amdgcn_fence(__ATOMIC_ACQUIRE, "agent");
            xb_add(&bar[XB_XGEN(b.x)], 1u);
            asm volatile("s_waitcnt vmcnt(0)" ::: "memory");
        } else {
            XB_SPIN(xb_ld(&bar[XB_XGEN(b.x)]) == gen, bar);
            __builtin_amdgcn_fence(__ATOMIC_ACQUIRE, "agent");
            asm volatile("s_waitcnt vmcnt(0)" ::: "memory");
        }
    }
    __syncthreads();
}


__global__ void __launch_bounds__(256, 2) hybrid_fwd(Params p, int ph_lo, int ph_hi) {
    __shared__ __attribute__((aligned(16))) unsigned char smem[SMEM];
    LAS unsigned char* lds = (LAS unsigned char*)smem;
    cg::grid_group grid = cg::this_grid();
    if (threadIdx.x < 2) *(LAS unsigned*)(lds + SM_FLAG + 16 + 4 * threadIdx.x) = 0u;
    __syncthreads();
    const XcdBarrier xb = xcd_barrier_post((unsigned*)(p.ws + W_BAR), (volatile LAS unsigned*)(lds + SM_FLAG + 16));
#define RUN_PHASE(k, call) if (ph_lo <= (k) && (k) <= ph_hi) { call; if ((k) < ph_hi) { if (ph_hi > 1000) grid.sync(); else xcd_barrier(xb); } }
    RUN_PHASE(0, phase0(p, lds))
    RUN_PHASE(1, phase1(p, lds))
    RUN_PHASE(2, phase2(p, lds))
    RUN_PHASE(3, phase2b(p, lds))
    RUN_PHASE(4, phase3a(p, lds))
    RUN_PHASE(5, phase3b(p, lds))
#undef RUN_PHASE
}

extern "C" void kernel_launch(void* const* d_in, const int* in_sizes, int n_in, void* d_out, int out_size, void* d_ws, size_t ws_size, hipStream_t stream) {
    (void)in_sizes; (void)n_in; (void)out_size;
    static int grid_blocks = 0;
    if (!grid_blocks) {
        int dev = 0, cus = 0, per_cu = 0;
        hipGetDevice(&dev);
        hipDeviceGetAttribute(&cus, hipDeviceAttributeMultiprocessorCount, dev);
        hipOccupancyMaxActiveBlocksPerMultiprocessor(&per_cu, hybrid_fwd, 256, 0);
        if (per_cu > 2) per_cu = 2;
        if (per_cu < 1) per_cu = 1;
        grid_blocks = cus * per_cu;
    }
    if (ws_size < W_END) { fprintf(stderr, "workspace too small: %zu < %zu\n", ws_size, (size_t)W_END); return; }
    Params p{};
    p.x_prompt = (const float*)d_in[0]; p.x_sample = (const float*)d_in[1]; p.cache_k = (const float*)d_in[2]; p.cache_v = (const float*)d_in[3];
    p.state_ret = (const float*)d_in[4]; p.norm_g = (const float*)d_in[5]; p.w_in = (const float*)d_in[6]; p.b_gate = (const float*)d_in[7];
    p.qn_g = (const float*)d_in[8]; p.kn_g = (const float*)d_in[9]; p.lam_q1 = (const float*)d_in[10]; p.lam_k1 = (const float*)d_in[11];
    p.lam_q2 = (const float*)d_in[12]; p.lam_k2 = (const float*)d_in[13]; p.subln_g = (const float*)d_in[14]; p.w_oa = (const float*)d_in[15];
    p.w_ob = (const float*)d_in[16]; p.w_out = (const float*)d_in[17];
    p.out = (float*)d_out; p.ws = (unsigned char*)d_ws;
    hipMemsetAsync((unsigned char*)d_ws + W_BAR, 0, 3456 * 4, stream);
    int lo = 0, hi = 5;
    void* args[] = {&p, &lo, &hi};
    hipError_t e = hipLaunchCooperativeKernel((void*)hybrid_fwd, dim3(grid_blocks), dim3(256), args, 0, stream);
    if (e != hipSuccess) fprintf(stderr, "cooperative launch failed: %s (grid %d)\n", hipGetErrorString(e), grid_blocks);
}
```

```cpp
#include <hip/hip_runtime.h>
#include <hip/hip_cooperative_groups.h>
#include <cstdio>
#include <cstdint>
namespace cg = cooperative_groups;

#define LAS __attribute__((address_space(3)))
typedef unsigned short bf16_t;
typedef short bf16x8 __attribute__((ext_vector_type(8)));
typedef float f32x4 __attribute__((ext_vector_type(4)));
typedef float f32x16 __attribute__((ext_vector_type(16)));
typedef unsigned u32x4 __attribute__((ext_vector_type(4)));
typedef unsigned u32x2 __attribute__((ext_vector_type(2)));

constexpr int DM = 1024, SEQ = 2048, PAST = 4096;
constexpr int MP = 8 * SEQ, MS = 8 * 64, MT = MP + MS;
constexpr int WIN = 6144;
constexpr float EPS = 1e-6f;
constexpr float LOG2E = 1.4426950408889634f;
constexpr int GC = 8, NG = 32 / GC;
constexpr int NSPLIT = 6;
__host__ __device__ constexpr int nsplit_of(int h) { return h == 0 ? 2 : h == 1 ? 4 : 9; }
__host__ __device__ constexpr int slot_of(int h) { return h == 0 ? 0 : h == 1 ? 2 : h == 2 ? 6 : 15; }

constexpr size_t O_YP = 0, O_YS = 16777216, O_KP = 17301504, O_VP = 25690112, O_RP = 34078720, O_KS = 34603008, O_VS = 34865152, O_RS = 35127296;

constexpr size_t SZ_H = (size_t)MT * 512 * 2;
constexpr size_t W_XN = 0;
constexpr size_t W_OAN = 0, W_OBN = SZ_H;
constexpr size_t W_RSTD = 2 * SZ_H;
constexpr size_t W_WINT = W_RSTD + 67584;
constexpr size_t W_WOAT = W_WINT + (size_t)6144 * 1024 * 2;
constexpr size_t W_WOBT = W_WOAT + 1048576;
constexpr size_t W_WOUTT = W_WOBT + 1048576;
constexpr size_t W_QA = W_WOUTT + 2097152;
constexpr size_t W_KA = W_QA + SZ_H;
constexpr size_t W_MB = W_QA;
constexpr size_t W_VAT = W_KA + SZ_H;
constexpr size_t W_SZA = W_VAT + SZ_H;
constexpr size_t W_QB = W_SZA + SZ_H;
constexpr size_t W_KB = W_QB + SZ_H;
constexpr size_t W_KBT = W_KB + SZ_H;
constexpr size_t W_VBT = W_KBT + SZ_H;
constexpr size_t W_SZB = W_VBT + SZ_H;
constexpr size_t W_GAS = W_SZB + SZ_H;
constexpr size_t W_GBS = W_GAS + 1048576;
constexpr size_t W_PO = W_WINT;
constexpr size_t W_PL = W_GBS + 1048576;
constexpr size_t W_CTR = W_PL + (size_t)32 * NSPLIT * 2 * 64 * 4;
constexpr size_t W_BAR = W_CTR + 256;
constexpr size_t W_OP = W_BAR + 3456 * 4;
constexpr size_t W_UG = W_OP + (size_t)MP * 512 * 4;
constexpr size_t W_END = W_UG + (size_t)32 * 8 * 128 * 128 * 4;
static_assert((size_t)32 * NSPLIT * 2 * 64 * 128 * 4 <= (size_t)6144 * 1024 * 2, "split partials must fit the WinT region");
static_assert(W_END <= (size_t)268435456, "workspace map exceeds 256 MiB");
constexpr size_t TSAMP = (size_t)8 * 4 * 128 * 2048;

constexpr int SMEM = 72192;
constexpr int SM_FLAG = 71680;

struct Params {
    const float *x_prompt, *x_sample, *cache_k, *cache_v, *state_ret, *norm_g, *w_in, *b_gate, *qn_g, *kn_g;
    const float *lam_q1, *lam_k1, *lam_q2, *lam_k2, *subln_g, *w_oa, *w_ob, *w_out;
    float* out;
    unsigned char* ws;
};

typedef float f32x2 __attribute__((ext_vector_type(2)));
typedef __bf16 bf16x2n __attribute__((ext_vector_type(2)));
__device__ __forceinline__ unsigned cvt_pk_bf16(float lo, float hi) { const f32x2 v = {lo, hi}; return __builtin_bit_cast(unsigned, __builtin_convertvector(v, bf16x2n)); }
__device__ __forceinline__ int opaque_tid() { int t = threadIdx.x; asm volatile("" : "+v"(t)); return t; }
__device__ __forceinline__ float bflo(unsigned u) { return __uint_as_float(u << 16); }
__device__ __forceinline__ float bfhi(unsigned u) { return __uint_as_float(u & 0xffff0000u); }
__device__ __forceinline__ bf16_t f2bf(float f) { return (bf16_t)(cvt_pk_bf16(f, 0.f) & 0xffffu); }
__device__ __forceinline__ float fexp2(float x) { return __builtin_amdgcn_exp2f(x); }
__device__ __forceinline__ float frcp(float x) { return __builtin_amdgcn_rcpf(x); }
__device__ __forceinline__ float sigmoidf_(float x) { return frcp(1.0f + fexp2(-LOG2E * x)); }
__device__ __forceinline__ f32x16 mfma32(bf16x8 a, bf16x8 b, f32x16 c) { return __builtin_amdgcn_mfma_f32_32x32x16_bf16(a, b, c, 0, 0, 0); }
__device__ __forceinline__ f32x4 mfma16(bf16x8 a, bf16x8 b, f32x4 c) { return __builtin_amdgcn_mfma_f32_16x16x32_bf16(a, b, c, 0, 0, 0); }
__device__ __forceinline__ bf16x8 pack8(const f32x16& s, int st) {
    u32x4 w;
    w.x = cvt_pk_bf16(s[8 * st + 0], s[8 * st + 1]); w.y = cvt_pk_bf16(s[8 * st + 2], s[8 * st + 3]);
    w.z = cvt_pk_bf16(s[8 * st + 4], s[8 * st + 5]); w.w = cvt_pk_bf16(s[8 * st + 6], s[8 * st + 7]);
    return __builtin_bit_cast(bf16x8, w);
}
__device__ __forceinline__ bf16x8 lds_rd16(const LAS unsigned char* p) { return *(const LAS bf16x8*)p; }
__device__ __forceinline__ bf16x8 lds_rd8x2(const LAS unsigned char* p) {
    u32x2 a = *(const LAS u32x2*)p, b = *(const LAS u32x2*)(p + 16);
    u32x4 w; w.x = a.x; w.y = a.y; w.z = b.x; w.w = b.y; return __builtin_bit_cast(bf16x8, w);
}
__device__ __forceinline__ bf16x8 lds_rd8c(const LAS unsigned char* p) {
    u32x2 a = *(const LAS u32x2*)p, b = *(const LAS u32x2*)(p + 8);
    u32x4 w; w.x = a.x; w.y = a.y; w.z = b.x; w.w = b.y; return __builtin_bit_cast(bf16x8, w);
}
__device__ __forceinline__ float log2_gamma(int h) { return log2f(1.0f - exp2f(-5.0f - (float)h)); }
__device__ __forceinline__ int accrow(int g, int hh) { return (g & 3) + 8 * (g >> 2) + 4 * hh; }
__device__ __forceinline__ int pi32(int r) { return (r & 19) | ((r & 4) << 1) | ((r & 8) >> 1); }
__device__ __forceinline__ int prow(int g, int hh) { return (g & 3) + 4 * ((g >> 2) & 1) + 8 * hh + 16 * (g >> 3); }

__device__ __forceinline__ int lds_byte(int r, int c) { const int st = (r >> 4) * 2 + (c >> 5), rr = r & 15, cc = c & 31, ob = rr * 64 + cc * 2; return st * 1024 + (ob ^ (((ob >> 9) & 1) << 5)); }
__device__ __forceinline__ void stage_rc(int b, int& R, int& C) { const int st = b / 1024, sb = b % 1024, swz = sb ^ (((sb >> 9) & 1) << 5); R = (st >> 1) * 16 + swz / 64; C = (st & 1) * 32 + (swz % 64) / 2; }

__device__ __forceinline__ void gemm_accum(f32x4 (&acc)[4][4], const bf16_t* __restrict__ A, int lda, const bf16_t* __restrict__ Bt, int ldb, int K, LAS unsigned char* lds) {
    const int tid = opaque_tid(), wid = __builtin_amdgcn_readfirstlane(tid >> 6), lane = tid & 63, wr = wid >> 1, wc = wid & 1, fr = lane & 15, fq = lane >> 4;
    unsigned offA[4], offB[4];
#pragma unroll
    for (int i = 0; i < 4; ++i) { const int R = (wid + 4 * i) * 8 + (lane >> 3), c = (lane & 7) ^ ((R >> 1) & 7); offA[i] = (unsigned)(R * lda + c * 8) * 2u; offB[i] = (unsigned)(R * ldb + c * 8) * 2u; }
    const int fo0 = fr * 128 + ((fq ^ (fr >> 1)) << 4), fo1 = fo0 ^ 64;
    const int aoff = wr * 8192, boff = 16384 + wc * 8192;
    const int nk = K >> 6;
    __syncthreads();
#define GEMM_STAGE(kt, buf) do { LAS unsigned char* la_ = lds + (buf) * 32768 + wid * 1024; \
        _Pragma("unroll") for (int i_ = 0; i_ < 4; ++i_) __builtin_amdgcn_global_load_lds((const unsigned*)((const char*)A + offA[i_] + (size_t)(kt) * 128), (LAS unsigned*)(la_ + i_ * 4096), 16, 0, 0); \
        _Pragma("unroll") for (int i_ = 0; i_ < 4; ++i_) __builtin_amdgcn_global_load_lds((const unsigned*)((const char*)Bt + offB[i_] + (size_t)(kt) * 128), (LAS unsigned*)(la_ + 16384 + i_ * 4096), 16, 0, 0); } while (0)
    GEMM_STAGE(0, 0);
    for (int kt = 0; kt < nk; ++kt) {
        asm volatile("s_waitcnt vmcnt(0)" ::: "memory");
        __syncthreads();
        if (kt + 1 < nk) GEMM_STAGE(kt + 1, (kt + 1) & 1);
        const LAS unsigned char* ps = lds + (kt & 1) * 32768;
        bf16x8 af[4][2], bfr[4][2];
#pragma unroll
        for (int m = 0; m < 4; ++m) { af[m][0] = lds_rd16(ps + aoff + m * 2048 + fo0); af[m][1] = lds_rd16(ps + aoff + m * 2048 + fo1); }
#pragma unroll
        for (int n = 0; n < 4; ++n) { bfr[n][0] = lds_rd16(ps + boff + n * 2048 + fo0); bfr[n][1] = lds_rd16(ps + boff + n * 2048 + fo1); }
#pragma unroll
        for (int kk = 0; kk < 2; ++kk)
#pragma unroll
            for (int m = 0; m < 4; ++m)
#pragma unroll
                for (int n = 0; n < 4; ++n) acc[m][n] = mfma16(bfr[n][kk], af[m][kk], acc[m][n]);
    }
#undef GEMM_STAGE
}
__device__ __forceinline__ void acc_zero(f32x4 (&acc)[4][4]) {
#pragma unroll
    for (int m = 0; m < 4; ++m)
#pragma unroll
        for (int n = 0; n < 4; ++n) acc[m][n] = (f32x4){0.f, 0.f, 0.f, 0.f};
}

__device__ void phase0(const Params& p, LAS unsigned char* lds) {
    const int tid = opaque_tid(), wid = tid >> 6, lane = tid & 63;
    bf16_t* XN = (bf16_t*)(p.ws + W_XN); float* RSTD = (float*)(p.ws + W_RSTD);
    if (blockIdx.x == 0) {
        unsigned* ctr = (unsigned*)(p.ws + W_CTR);
        if (tid < 40) ctr[tid] = 0u;
        if (tid >= 56 && tid < 60) ctr[tid] = 0u;
        if (wid == 1) {
            float a = p.lam_q1[lane] * p.lam_k1[lane], b = p.lam_q2[lane] * p.lam_k2[lane];
            float gq = fabsf(p.qn_g[lane]), gk = fabsf(p.kn_g[lane]);
#pragma unroll
            for (int o = 32; o >= 1; o >>= 1) { a += __shfl_xor(a, o); b += __shfl_xor(b, o); gq = fmaxf(gq, __shfl_xor(gq, o)); gk = fmaxf(gk, __shfl_xor(gk, o)); }
            if (lane == 0) { float* sc = (float*)(p.ws + W_CTR); sc[40] = expf(a) - expf(b) + 0.2f; sc[41] = 8.0f * gq * gk * LOG2E; }
        }
    }
    const int gw = blockIdx.x * 4 + wid, nw = gridDim.x * 4;
    for (int row = gw; row < MT; row += nw) {
        const float* xr = row < MP ? p.x_prompt + (size_t)row * DM : p.x_sample + (size_t)(row - MP) * DM;
        f32x4 v[4]; float ss = 0.f;
#pragma unroll
        for (int i = 0; i < 4; ++i) { v[i] = *(const f32x4*)(xr + i * 256 + lane * 4); ss += v[i][0] * v[i][0] + v[i][1] * v[i][1] + v[i][2] * v[i][2] + v[i][3] * v[i][3]; }
#pragma unroll
        for (int o = 32; o >= 1; o >>= 1) ss += __shfl_xor(ss, o);
        if (lane == 0) RSTD[row] = rsqrtf(ss * (1.0f / 1024.0f) + EPS);
        f32x4 gn[4];
#pragma unroll
        for (int i = 0; i < 4; ++i) gn[i] = *(const f32x4*)(p.norm_g + i * 256 + lane * 4);
#pragma unroll
        for (int i = 0; i < 4; ++i) { const f32x4 g = gn[i]; u32x2 w; w.x = cvt_pk_bf16(v[i][0] * g[0], v[i][1] * g[1]); w.y = cvt_pk_bf16(v[i][2] * g[2], v[i][3] * g[3]);
            *(u32x2*)(XN + (size_t)row * DM + i * 256 + lane * 4) = w; }
    }
    LAS float* tile = (LAS float*)lds;
    const int tx = tid & 63, ty = tid >> 6;
    for (int t = blockIdx.x; t < 2048; t += gridDim.x) {
        const float* src; bf16_t* dst; int K, N, tt;
        if (t < 1536) { src = p.w_in; dst = (bf16_t*)(p.ws + W_WINT); K = 1024; N = 6144; tt = t; }
        else if (t < 1664) { src = p.w_oa; dst = (bf16_t*)(p.ws + W_WOAT); K = 512; N = 1024; tt = t - 1536; }
        else if (t < 1792) { src = p.w_ob; dst = (bf16_t*)(p.ws + W_WOBT); K = 512; N = 1024; tt = t - 1664; }
        else { src = p.w_out; dst = (bf16_t*)(p.ws + W_WOUTT); K = 1024; N = 1024; tt = t - 1792; }
        const int ntn = N >> 6, k0 = (tt / ntn) * 64, n0 = (tt % ntn) * 64;
        __syncthreads();
        float tv[16];
#pragma unroll
        for (int i = 0; i < 16; ++i) tv[i] = src[(size_t)(k0 + ty + 4 * i) * N + n0 + tx];
#pragma unroll
        for (int i = 0; i < 16; ++i) tile[(ty + 4 * i) * 65 + tx] = tv[i];
        __syncthreads();
#pragma unroll
        for (int i = 0; i < 16; ++i) dst[(size_t)(n0 + ty + 4 * i) * K + k0 + tx] = f2bf(tile[tx * 65 + ty + 4 * i]);
    }
}

__device__ __forceinline__ void epi_inproj(const Params& p, f32x4 (&acc)[4][4], int pm, int pn, LAS unsigned char* lds) {
    const int tid = opaque_tid(), wid = tid >> 6, lane = tid & 63, wr = wid >> 1, wc = wid & 1, fr = lane & 15, fq = lane >> 4;
    const int colw = pn * 128 + wc * 64, seg = colw >> 9, c0 = (colw & 511) + fq * 4;
    const bool samp = pm * 128 >= MP;
    const float* RSTD = (const float*)(p.ws + W_RSTD);
    unsigned char* ws = p.ws;
    float rsv[4];
#pragma unroll
    for (int m = 0; m < 4; ++m) rsv[m] = RSTD[pm * 128 + wr * 64 + m * 16 + fr];
    f32x4 gv[4];
    {
        const float* gsrc = seg == 0 ? p.qn_g + (c0 & 63) : seg == 1 ? p.kn_g + (c0 & 63) : seg >= 8 ? p.b_gate + (seg >= 10 ? 1024 : 0) + colw - (seg >= 10 ? 5120 : 4096) + fq * 4 : p.qn_g;
#pragma unroll
        for (int n = 0; n < 4; ++n) gv[n] = *(const f32x4*)(gsrc + n * 16);
    }
    __builtin_amdgcn_sched_barrier(0);
    __syncthreads();
    LAS unsigned char* NT = lds; LAS unsigned char* TT = lds + 34816;
#pragma unroll
    for (int m = 0; m < 4; ++m) {
        const int r = pm * 128 + wr * 64 + m * 16 + fr;
        const int lrow = wr * 64 + m * 16 + fr, lcol = wc * 64 + fq * 4;
        const float rs = rsv[m];
        f32x4 v[4];
#pragma unroll
        for (int n = 0; n < 4; ++n) v[n] = acc[m][n] * rs;
        const int rl = samp ? r - MP : r;
        const int tb = samp ? (rl >> 6) : (rl >> 11), tt = samp ? (rl & 63) : (rl & 2047), tstr = samp ? 64 : 2048;
        const size_t tbase = (samp ? TSAMP : 0) + (size_t)tb * 4 * 128 * tstr + tt;
        if (seg <= 1) {
            float ss = 0.f;
#pragma unroll
            for (int n = 0; n < 4; ++n) ss += v[n][0] * v[n][0] + v[n][1] * v[n][1] + v[n][2] * v[n][2] + v[n][3] * v[n][3];
            ss += __shfl_xor(ss, 16); ss += __shfl_xor(ss, 32);
            const float inv = rsqrtf(ss * (1.0f / 64.0f) + EPS);
            const float sc = seg == 0 ? inv * (0.125f * LOG2E) : inv;
            float* dstf = p.out + (samp ? O_KS + (size_t)rl * 512 : O_KP + (size_t)rl * 512);
#pragma unroll
            for (int n = 0; n < 4; ++n) {
                const int c = c0 + n * 16; const f32x4 g = gv[n];
                f32x4 o; o[0] = v[n][0] * sc * g[0]; o[1] = v[n][1] * sc * g[1]; o[2] = v[n][2] * sc * g[2]; o[3] = v[n][3] * sc * g[3];
                u32x2 w; w.x = cvt_pk_bf16(o[0], o[1]); w.y = cvt_pk_bf16(o[2], o[3]);
                *(LAS u32x2*)(NT + lrow * 272 + (lcol + n * 16) * 2) = w;
                if (seg == 1) *(f32x4*)(dstf + c) = o;
            }
        } else if (seg == 2 || seg == 6) {
            float* dstf = p.out + (samp ? O_VS + (size_t)rl * 512 : O_VP + (size_t)rl * 512);
#pragma unroll
            for (int n = 0; n < 4; ++n) {
                const int c = c0 + n * 16;
                if (seg == 2) *(f32x4*)(dstf + c) = v[n];
#pragma unroll
                for (int j = 0; j < 4; ++j) *(LAS bf16_t*)(TT + (lcol + n * 16 + j) * 272 + lrow * 2) = f2bf(v[n][j]);
            }
        } else if (seg == 3 || seg == 7) {
#pragma unroll
            for (int n = 0; n < 4; ++n) {
                const int c = c0 + n * 16; f32x4 o;
#pragma unroll
                for (int j = 0; j < 4; ++j) o[j] = v[n][j] * sigmoidf_(v[n][j]);
                u32x2 w; w.x = cvt_pk_bf16(o[0], o[1]); w.y = cvt_pk_bf16(o[2], o[3]);
                *(LAS u32x2*)(NT + lrow * 272 + (lcol + n * 16) * 2) = w;
            }
        } else if (seg == 4) {
#pragma unroll
            for (int n = 0; n < 4; ++n) { u32x2 w; w.x = cvt_pk_bf16(v[n][0], v[n][1]); w.y = cvt_pk_bf16(v[n][2], v[n][3]); *(LAS u32x2*)(NT + lrow * 272 + (lcol + n * 16) * 2) = w; }
        } else if (seg == 5) {
            const int hh = c0 >> 7;
            const float zeta = fexp2((float)(63 - (r & 63)) * log2_gamma(hh));
            const float ksc = 0.08838834764831845f;
#pragma unroll
            for (int n = 0; n < 4; ++n) {
                const int c = c0 + n * 16; f32x4 o = v[n] * ksc;
                u32x2 w; w.x = cvt_pk_bf16(o[0], o[1]); w.y = cvt_pk_bf16(o[2], o[3]); *(LAS u32x2*)(NT + lrow * 272 + (lcol + n * 16) * 2) = w;
#pragma unroll
                for (int j = 0; j < 4; ++j) *(LAS bf16_t*)(TT + (lcol + n * 16 + j) * 272 + lrow * 2) = f2bf(o[j] * zeta);
            }
        } else {
#pragma unroll
            for (int n = 0; n < 4; ++n) {
                const f32x4 b = gv[n]; f32x4 o;
#pragma unroll
                for (int j = 0; j < 4; ++j) o[j] = sigmoidf_(v[n][j] + b[j]);
                u32x2 w; w.x = cvt_pk_bf16(o[0], o[1]); w.y = cvt_pk_bf16(o[2], o[3]); *(LAS u32x2*)(NT + lrow * 272 + (lcol + n * 16) * 2) = w;
            }
        }
    }
    __syncthreads();
    const int rl0 = pm * 128 - (samp ? MP : 0), ct = (pn * 128) & 511;
    if (seg != 2 && seg != 6) {
        bf16_t* dst; int ld;
        if (seg < 8) { const size_t wo = seg == 0 ? W_QA : seg == 1 ? W_KA : seg == 3 ? W_SZA : seg == 4 ? W_QB : seg == 5 ? W_KB : W_SZB; dst = (bf16_t*)(ws + wo) + (size_t)(pm * 128) * 512 + ct; ld = 512; }
        else { const int which = seg >= 10, cg = pn * 128 - (which ? 5120 : 4096);
               dst = (samp ? (bf16_t*)(ws + (which ? W_GBS : W_GAS)) : (bf16_t*)p.out + (which ? (size_t)MP * 1024 : 0)) + (size_t)rl0 * 1024 + cg; ld = 1024; }
        u32x4 tv[8];
#pragma unroll
        for (int i = 0; i < 8; ++i) { const int q = tid + 256 * i; tv[i] = *(const LAS u32x4*)(NT + (q >> 4) * 272 + (q & 15) * 16); }
#pragma unroll
        for (int i = 0; i < 8; ++i) { const int q = tid + 256 * i; *(u32x4*)(dst + (size_t)(q >> 4) * ld + (q & 15) * 8) = tv[i]; }
    }
    if (seg == 2 || seg == 5 || seg == 6) {
        bf16_t* dstt = (bf16_t*)(ws + (seg == 2 ? W_VAT : seg == 5 ? W_KBT : W_VBT));
        const int tstr = samp ? 64 : 2048;
        u32x4 tv[8];
#pragma unroll
        for (int i = 0; i < 8; ++i) { const int q = tid + 256 * i; tv[i] = *(const LAS u32x4*)(TT + (q >> 4) * 272 + (q & 15) * 16); }
#pragma unroll
        for (int i = 0; i < 8; ++i) {
            const int q = tid + 256 * i, cl = q >> 4, rl = rl0 + (q & 15) * 8;
            const size_t tb = samp ? TSAMP + (size_t)(rl >> 6) * 4 * 128 * 64 + (rl & 63) : (size_t)(rl >> 11) * 4 * 128 * 2048 + (rl & 2047);
            *(u32x4*)(dstt + tb + (size_t)(ct + cl) * tstr) = tv[i];
        }
    }
}

__device__ void phase1(const Params& p, LAS unsigned char* lds) {
    const bf16_t* XN = (const bf16_t*)(p.ws + W_XN); const bf16_t* WT = (const bf16_t*)(p.ws + W_WINT);
    constexpr int NSM = 17, NSN = 6, NSUP = NSM * NSN, NSLOT = ((NSUP + 7) / 8) * 8 * 64;
    for (int tile = blockIdx.x; tile < NSLOT; tile += gridDim.x) {
        const int xcd = tile & 7, q = tile >> 3, S = (q >> 6) * 8 + xcd, within = q & 63;
        if (S >= NSUP) continue;
        const int pm = (S % NSM) * 8 + (within & 7), pn = (S / NSM) * 8 + (within >> 3);
        if (pm >= 132) continue;
        f32x4 acc[4][4]; acc_zero(acc);
        gemm_accum(acc, XN + (size_t)pm * 128 * DM, DM, WT + (size_t)pn * 128 * DM, DM, DM, lds);
        epi_inproj(p, acc, pm, pn, lds);
    }
}

template <bool WT>
__device__ __forceinline__ void p3a_tile(const Params& p, LAS unsigned char* lds, int pm, int pn) {
    const int tid = opaque_tid(), wid = tid >> 6, lane = tid & 63, wr = wid >> 1, wc = wid & 1, fr = lane & 15, fq = lane >> 4;
    const bf16_t* OAN = (const bf16_t*)(p.ws + W_OAN); const bf16_t* OBN = (const bf16_t*)(p.ws + W_OBN);
    const bf16_t* WA = (const bf16_t*)(p.ws + W_WOAT); const bf16_t* WB = (const bf16_t*)(p.ws + W_WOBT);
    bf16_t* MB = (bf16_t*)(p.ws + W_MB);
    const bool samp = pm * 128 >= MP;
    f32x4 acc[4][4]; acc_zero(acc);
    gemm_accum(acc, OAN + (size_t)pm * 128 * 512, 512, WA + (size_t)pn * 128 * 512, 512, 512, lds);
    const int cbase = pn * 128 + wc * 64 + fq * 4;
#pragma unroll
    for (int m = 0; m < 4; ++m) {
        const int r = pm * 128 + wr * 64 + m * 16 + fr, rl = samp ? r - MP : r;
        const bf16_t* ga = samp ? (const bf16_t*)(p.ws + W_GAS) + (size_t)rl * 1024 : (const bf16_t*)p.out + (size_t)rl * 1024;
        const bf16_t* gb = samp ? (const bf16_t*)(p.ws + W_GBS) + (size_t)rl * 1024 : (const bf16_t*)p.out + (size_t)MP * 1024 + (size_t)rl * 1024;
        u32x2 av[4], bv[4];
#pragma unroll
        for (int n = 0; n < 4; ++n) { av[n] = *(const u32x2*)(ga + cbase + n * 16); bv[n] = *(const u32x2*)(gb + cbase + n * 16); }
        __builtin_amdgcn_sched_barrier(0);
#pragma unroll
        for (int n = 0; n < 4; ++n) {
            const u32x2 a = av[n], b = bv[n];
            acc[m][n][0] *= bflo(a.x) * frcp(bflo(b.x)); acc[m][n][1] *= bfhi(a.x) * frcp(bfhi(b.x)); acc[m][n][2] *= bflo(a.y) * frcp(bflo(b.y)); acc[m][n][3] *= bfhi(a.y) * frcp(bfhi(b.y));
        }
    }
    gemm_accum(acc, OBN + (size_t)pm * 128 * 512, 512, WB + (size_t)pn * 128 * 512, 512, 512, lds);
#pragma unroll
    for (int m = 0; m < 4; ++m) {
        const int r = pm * 128 + wr * 64 + m * 16 + fr, rl = samp ? r - MP : r;
        const bf16_t* gb = samp ? (const bf16_t*)(p.ws + W_GBS) + (size_t)rl * 1024 : (const bf16_t*)p.out + (size_t)MP * 1024 + (size_t)rl * 1024;
        u32x2 bv[4];
#pragma unroll
        for (int n = 0; n < 4; ++n) bv[n] = *(const u32x2*)(gb + cbase + n * 16);
        __builtin_amdgcn_sched_barrier(0);
#pragma unroll
        for (int n = 0; n < 4; ++n) {
            const u32x2 b = bv[n];
            u32x2 w; w.x = cvt_pk_bf16(acc[m][n][0] * bflo(b.x), acc[m][n][1] * bfhi(b.x)); w.y = cvt_pk_bf16(acc[m][n][2] * bflo(b.y), acc[m][n][3] * bfhi(b.y));
            if constexpr (WT) __hip_atomic_store((unsigned long long*)(MB + (size_t)r * 1024 + cbase + n * 16), ((unsigned long long)w.y << 32) | w.x, __ATOMIC_RELAXED, __HIP_MEMORY_SCOPE_AGENT);
            else *(u32x2*)(MB + (size_t)r * 1024 + cbase + n * 16) = w;
        }
    }
}
__device__ __forceinline__ void p3b_tile(const Params& p, LAS unsigned char* lds, int pm, int pn) {
    const int tid = opaque_tid(), wid = tid >> 6, lane = tid & 63, wr = wid >> 1, wc = wid & 1, fr = lane & 15, fq = lane >> 4;
    const bf16_t* MB = (const bf16_t*)(p.ws + W_MB); const bf16_t* WO = (const bf16_t*)(p.ws + W_WOUTT);
    const bool samp = pm * 128 >= MP;
    f32x4 acc[4][4]; acc_zero(acc);
    gemm_accum(acc, MB + (size_t)pm * 128 * 1024, 1024, WO + (size_t)pn * 128 * 1024, 1024, 1024, lds);
    const int cbase = pn * 128 + wc * 64 + fq * 4;
#pragma unroll
    for (int m = 0; m < 4; ++m) {
        const int r = pm * 128 + wr * 64 + m * 16 + fr, rl = samp ? r - MP : r;
        const float* xr = (samp ? p.x_sample : p.x_prompt) + (size_t)rl * 1024;
        float* yr = p.out + (samp ? O_YS : O_YP) + (size_t)rl * 1024;
        f32x4 xv[4];
#pragma unroll
        for (int n = 0; n < 4; ++n) xv[n] = *(const f32x4*)(xr + cbase + n * 16);
        __builtin_amdgcn_sched_barrier(0);
#pragma unroll
        for (int n = 0; n < 4; ++n) *(f32x4*)(yr + cbase + n * 16) = xv[n] + acc[m][n];
    }
}
__device__ void phase3a(const Params& p, LAS unsigned char* lds) {
    constexpr int NSUP = 32, NSLOT = NSUP * 32;
    for (int tile = blockIdx.x; tile < NSLOT; tile += gridDim.x) {
        const int xcd = tile & 7, q = tile >> 3, S = (q >> 5) * 8 + xcd, within = q & 31;
        p3a_tile<false>(p, lds, S * 4 + (within & 3), within >> 2);
    }
}
__device__ void phase3b(const Params& p, LAS unsigned char* lds) {
    constexpr int NSUP = 32, NSLOT = NSUP * 32;
    for (int tile = blockIdx.x; tile < NSLOT; tile += gridDim.x) {
        const int xcd = tile & 7, q = tile >> 3, S = (q >> 5) * 8 + xcd, within = q & 31;
        p3b_tile(p, lds, S * 4 + (within & 3), within >> 2);
    }
}

constexpr int KS_STR = 272, VT_STR = 144, OX_STR = 132;
template <bool INLDS>
__device__ __forceinline__ void attn_finalize(const float* O, const float* L, int nsplit, int sstrO, int sstrL, int ostr, float lam, const float* __restrict__ gain, float gscale,
                                              const bf16_t* __restrict__ sz, bf16_t* __restrict__ dst, int row0, int h) {
    const int tid = opaque_tid(), t = tid >> 2, q = tid & 3;
    float l0 = 0.f, l1 = 0.f; f32x4 a0[8], a1[8];
#pragma unroll
    for (int i = 0; i < 8; ++i) { a0[i] = (f32x4){0.f, 0.f, 0.f, 0.f}; a1[i] = (f32x4){0.f, 0.f, 0.f, 0.f}; }
    for (int s = 0; s < nsplit; ++s) {
        f32x4 t0[8], t1[8];
        if constexpr (INLDS) {
            const LAS float* Ll = (const LAS float*)L; const LAS float* o0 = (const LAS float*)O + t * ostr + q * 32; const LAS float* o1 = o0 + 64 * ostr;
            l0 += Ll[t]; l1 += Ll[64 + t];
#pragma unroll
            for (int i = 0; i < 8; ++i) { t0[i] = *(const LAS f32x4*)(o0 + 4 * i); t1[i] = *(const LAS f32x4*)(o1 + 4 * i); }
        } else {
            l0 += L[s * sstrL + t]; l1 += L[s * sstrL + 64 + t];
            const float* o0 = O + (size_t)s * sstrO + t * ostr + q * 32; const float* o1 = o0 + 64 * ostr;
#pragma unroll
            for (int i = 0; i < 8; ++i) { t0[i] = *(const f32x4*)(o0 + 4 * i); t1[i] = *(const f32x4*)(o1 + 4 * i); }
        }
        __builtin_amdgcn_sched_barrier(0);
#pragma unroll
        for (int i = 0; i < 8; ++i) { a0[i] += t0[i]; a1[i] += t1[i]; }
    }
    const float c0 = 1.0f / l0, c1 = lam / l1; float ss = 0.f;
#pragma unroll
    for (int i = 0; i < 8; ++i) { a0[i] = a0[i] * c0 - a1[i] * c1; ss += a0[i][0] * a0[i][0] + a0[i][1] * a0[i][1] + a0[i][2] * a0[i][2] + a0[i][3] * a0[i][3]; }
    ss += __shfl_xor(ss, 1); ss += __shfl_xor(ss, 2);
    const float inv = rsqrtf(ss * (1.0f / 128.0f) + EPS) * gscale;
    const size_t base = (size_t)(row0 + t) * 512 + h * 128 + q * 32;
    u32x4 zz[4]; f32x4 gg[8];
#pragma unroll
    for (int i = 0; i < 4; ++i) { zz[i] = *(const u32x4*)(sz + base + 8 * i); gg[2 * i] = *(const f32x4*)(gain + q * 32 + 8 * i); gg[2 * i + 1] = *(const f32x4*)(gain + q * 32 + 8 * i + 4); }
    __builtin_amdgcn_sched_barrier(0);
#pragma unroll
    for (int i = 0; i < 4; ++i) {
        const u32x4 z = zz[i];
        const f32x4 g0 = gg[2 * i], g1 = gg[2 * i + 1];
        const f32x4 x0 = a0[2 * i], x1 = a0[2 * i + 1]; u32x4 w;
        w.x = cvt_pk_bf16(x0[0] * inv * g0[0] * bflo(z.x), x0[1] * inv * g0[1] * bfhi(z.x));
        w.y = cvt_pk_bf16(x0[2] * inv * g0[2] * bflo(z.y), x0[3] * inv * g0[3] * bfhi(z.y));
        w.z = cvt_pk_bf16(x1[0] * inv * g1[0] * bflo(z.z), x1[1] * inv * g1[1] * bfhi(z.z));
        w.w = cvt_pk_bf16(x1[2] * inv * g1[2] * bflo(z.w), x1[3] * inv * g1[3] * bfhi(z.w));
        *(u32x4*)(dst + base + 8 * i) = w;
    }
}

__device__ __forceinline__ void attn_item(const Params& p, LAS unsigned char* lds, bool samp, int b, int h, int idx) {
    const int tid = opaque_tid(), wid = tid >> 6, lane = tid & 63, r = lane & 31, hh = lane >> 5, qh = wid & 1, c = wid >> 1;
    const bf16_t* QA = (const bf16_t*)(p.ws + W_QA); const bf16_t* KA = (const bf16_t*)(p.ws + W_KA); const bf16_t* VAT = (const bf16_t*)(p.ws + W_VAT);
    const float* scal = (const float*)(p.ws + W_CTR);
    const float lam = scal[40], C2 = scal[41];
    int qrow0, qpos0, j0, j1;
    if (!samp) { qrow0 = b * 2048 + 64 * idx; qpos0 = 64 * idx; const int Tp = (111 << (2 * h + 2)) + 63; j0 = qpos0 >= Tp ? ((qpos0 - Tp) >> 6) + 1 : 0; j1 = idx + 1; }
    else {
        const int Th = (111 << (2 * h + 2)) + 63;
        const int jmin = PAST >= Th ? ((PAST - Th) >> 6) + 1 : 0, nt = 65 - jmin;
        const int nsh = nsplit_of(h);
        qrow0 = MP + b * 64; qpos0 = PAST; j0 = jmin + idx * nt / nsh; j1 = jmin + (idx + 1) * nt / nsh;
    }
    bf16x8 qf[4];
    { const bf16_t* qp = QA + (size_t)(qrow0 + 32 * qh + r) * 512 + h * 128 + c * 64 + 8 * hh;
#pragma unroll
      for (int kk = 0; kk < 4; ++kk) qf[kk] = *(const bf16x8*)(qp + 16 * kk); }
    const float sl2 = exp2f(-2.0f * (float)(h + 1)) * LOG2E;
    const float qposf = (float)(qpos0 + 32 * qh + r);
    f32x16 O[4];
#pragma unroll
    for (int dt = 0; dt < 4; ++dt)
#pragma unroll
        for (int g = 0; g < 16; ++g) O[dt][g] = 0.f;
    float lsum = 0.f;
    LAS unsigned char* Ks = lds; LAS unsigned char* Vt = lds + 17408;
    const int pr = pi32(r);
    u32x4 stg[16];
    const int tid_ = tid;
    auto issue = [&](int j) {
        int tid = tid_; asm volatile("" : "+v"(tid));
        if (samp && j < 64) {
            const float* kc = p.cache_k + (((size_t)b * PAST + 64 * j) * 4 + h) * 128;
            const float* vc = p.cache_v + (((size_t)b * PAST + 64 * j) * 4 + h) * 128;
            const int kg = tid >> 5, piece = tid & 31;
#pragma unroll
            for (int i = 0; i < 8; ++i) stg[i] = *(const u32x4*)(kc + (size_t)(kg + 8 * i) * 512 + piece * 4);
#pragma unroll
            for (int i = 0; i < 8; ++i) stg[8 + i] = *(const u32x4*)(vc + (size_t)(8 * kg + i) * 512 + piece * 4);
        } else {
            const int krow0 = samp ? MP + b * 64 : b * 2048 + 64 * j;
            const bf16_t* kp = KA + (size_t)krow0 * 512 + h * 128;
            const bf16_t* vp = samp ? VAT + TSAMP + (size_t)(b * 4 + h) * 128 * 64 : VAT + (size_t)(b * 4 + h) * 128 * 2048 + 64 * j;
            const int vstr = samp ? 64 : 2048;
#pragma unroll
            for (int i = 0; i < 4; ++i) stg[i] = *(const u32x4*)(kp + (size_t)((tid >> 4) + 16 * i) * 512 + (tid & 15) * 8);
#pragma unroll
            for (int i = 0; i < 4; ++i) stg[4 + i] = *(const u32x4*)(vp + (size_t)((tid >> 3) + 32 * i) * vstr + (tid & 7) * 8);
        }
    };
    auto commit = [&](int j, LAS unsigned char* Kd, LAS unsigned char* Vd) {
        int tid = tid_; asm volatile("" : "+v"(tid));
        if (samp && j < 64) {
            const int kg = tid >> 5, piece = tid & 31;
#pragma unroll
            for (int i = 0; i < 8; ++i) { u32x2 w; w.x = cvt_pk_bf16(__uint_as_float(stg[i].x), __uint_as_float(stg[i].y)); w.y = cvt_pk_bf16(__uint_as_float(stg[i].z), __uint_as_float(stg[i].w)); *(LAS u32x2*)(Kd + (kg + 8 * i) * KS_STR + piece * 8) = w; }
            { u32x4 w; w.x = cvt_pk_bf16(__uint_as_float(stg[8].x), __uint_as_float(stg[9].x)); w.y = cvt_pk_bf16(__uint_as_float(stg[10].x), __uint_as_float(stg[11].x)); w.z = cvt_pk_bf16(__uint_as_float(stg[12].x), __uint_as_float(stg[13].x)); w.w = cvt_pk_bf16(__uint_as_float(stg[14].x), __uint_as_float(stg[15].x)); *(LAS u32x4*)(Vd + (4 * piece + 0) * VT_STR + kg * 16) = w; }
            { u32x4 w; w.x = cvt_pk_bf16(__uint_as_float(stg[8].y), __uint_as_float(stg[9].y)); w.y = cvt_pk_bf16(__uint_as_float(stg[10].y), __uint_as_float(stg[11].y)); w.z = cvt_pk_bf16(__uint_as_float(stg[12].y), __uint_as_float(stg[13].y)); w.w = cvt_pk_bf16(__uint_as_float(stg[14].y), __uint_as_float(stg[15].y)); *(LAS u32x4*)(Vd + (4 * piece + 1) * VT_STR + kg * 16) = w; }
            { u32x4 w; w.x = cvt_pk_bf16(__uint_as_float(stg[8].z), __uint_as_float(stg[9].z)); w.y = cvt_pk_bf16(__uint_as_float(stg[10].z), __uint_as_float(stg[11].z)); w.z = cvt_pk_bf16(__uint_as_float(stg[12].z), __uint_as_float(stg[13].z)); w.w = cvt_pk_bf16(__uint_as_float(stg[14].z), __uint_as_float(stg[15].z)); *(LAS u32x4*)(Vd + (4 * piece + 2) * VT_STR + kg * 16) = w; }
            { u32x4 w; w.x = cvt_pk_bf16(__uint_as_float(stg[8].w), __uint_as_float(stg[9].w)); w.y = cvt_pk_bf16(__uint_as_float(stg[10].w), __uint_as_float(stg[11].w)); w.z = cvt_pk_bf16(__uint_as_float(stg[12].w), __uint_as_float(stg[13].w)); w.w = cvt_pk_bf16(__uint_as_float(stg[14].w), __uint_as_float(stg[15].w)); *(LAS u32x4*)(Vd + (4 * piece + 3) * VT_STR + kg * 16) = w; }
        } else {
#pragma unroll
            for (int i = 0; i < 4; ++i) *(LAS u32x4*)(Kd + ((tid >> 4) + 16 * i) * KS_STR + (tid & 15) * 16) = stg[i];
#pragma unroll
            for (int i = 0; i < 4; ++i) *(LAS u32x4*)(Vd + ((tid >> 3) + 32 * i) * VT_STR + (tid & 7) * 16) = stg[4 + i];
        }
    };
    issue(j0);
    __syncthreads();
    commit(j0, Ks, Vt);
    __syncthreads();
    for (int j = j0; j < j1; ++j) {
        const int cur = (j - j0) & 1;
        const LAS unsigned char* Kc = Ks + cur * 35840; const LAS unsigned char* Vc = Vt + cur * 35840;
        if (j + 1 < j1) issue(j + 1);
        __builtin_amdgcn_sched_barrier(0);
#pragma unroll
        for (int si = 0; si < 2; ++si) {
            f32x16 s;
#pragma unroll
            for (int g = 0; g < 16; ++g) s[g] = 0.f;
#pragma unroll
            for (int kk = 0; kk < 4; ++kk) { const bf16x8 kf = lds_rd16(Kc + (32 * si + pr) * KS_STR + (c * 64 + 16 * kk + 8 * hh) * 2); s = mfma32(kf, qf[kk], s); }
#pragma unroll
            for (int g = 0; g < 16; ++g) {
                const float kposf = (float)(64 * j + 32 * si + prow(g, hh));
                const float e = fexp2(s[g] - sl2 * fabsf(qposf - kposf) - C2);
                lsum += e; s[g] = e;
            }
#pragma unroll
            for (int st = 0; st < 2; ++st) {
                const bf16x8 pb = pack8(s, st);
#pragma unroll
                for (int dt = 0; dt < 4; ++dt) { const bf16x8 vf = lds_rd16(Vc + (32 * dt + r) * VT_STR + (32 * si + 16 * st + 8 * hh) * 2); O[dt] = mfma32(vf, pb, O[dt]); }
            }
        }
        __builtin_amdgcn_sched_barrier(0);
        if (j + 1 < j1) commit(j + 1, Ks + (cur ^ 1) * 35840, Vt + (cur ^ 1) * 35840);
        __syncthreads();
    }
    lsum += __shfl_xor(lsum, 32);
    __syncthreads();
    const bf16_t* SZA = (const bf16_t*)(p.ws + W_SZA); bf16_t* OAN = (bf16_t*)(p.ws + W_OAN);
    if (!samp) {
        LAS float* OX = (LAS float*)lds; LAS float* LX = (LAS float*)(lds + 67584);
#pragma unroll
        for (int dt = 0; dt < 4; ++dt)
#pragma unroll
            for (int g4 = 0; g4 < 4; ++g4)
                *(LAS f32x4*)(OX + (c * 64 + 32 * qh + r) * OX_STR + 32 * dt + 8 * g4 + 4 * hh) = (f32x4){O[dt][4 * g4], O[dt][4 * g4 + 1], O[dt][4 * g4 + 2], O[dt][4 * g4 + 3]};
        if (hh == 0) LX[c * 64 + 32 * qh + r] = lsum;
        __syncthreads();
        attn_finalize<true>((const float*)OX, (const float*)LX, 1, 0, 0, OX_STR, lam, p.subln_g, 0.8f, SZA, OAN, qrow0, h);
    } else {
        const int bh = b * 4 + h;
        const int slot0 = b * 4 * NSPLIT + slot_of(h), nsh = nsplit_of(h);
        float* PO = (float*)(p.ws + W_PO) + (size_t)slot0 * 2 * 64 * 128; float* PL = (float*)(p.ws + W_PL) + (size_t)slot0 * 128;
        float* po = PO + (size_t)idx * 2 * 64 * 128; float* pl = PL + idx * 128;
#pragma unroll
        for (int dt = 0; dt < 4; ++dt)
#pragma unroll
            for (int g4 = 0; g4 < 4; ++g4)
            {
                unsigned long long* q8 = (unsigned long long*)(po + (c * 64 + 32 * qh + r) * 128 + 32 * dt + 8 * g4 + 4 * hh);
                __hip_atomic_store(q8, ((unsigned long long)__float_as_uint(O[dt][4 * g4 + 1]) << 32) | __float_as_uint(O[dt][4 * g4]), __ATOMIC_RELAXED, __HIP_MEMORY_SCOPE_AGENT);
                __hip_atomic_store(q8 + 1, ((unsigned long long)__float_as_uint(O[dt][4 * g4 + 3]) << 32) | __float_as_uint(O[dt][4 * g4 + 2]), __ATOMIC_RELAXED, __HIP_MEMORY_SCOPE_AGENT);
            }
        if (hh == 0) __hip_atomic_store((unsigned*)(pl + c * 64 + 32 * qh + r), __float_as_uint(lsum), __ATOMIC_RELAXED, __HIP_MEMORY_SCOPE_AGENT);
        asm volatile("s_waitcnt vmcnt(0)" ::: "memory");
        __syncthreads();
        if (tid == 0) {
            const unsigned old = __hip_atomic_fetch_add((unsigned*)(p.ws + W_CTR) + bh, 1u, __ATOMIC_RELAXED, __HIP_MEMORY_SCOPE_AGENT);
            const unsigned last = (old == (unsigned)(nsh - 1)) ? 1u : 0u;
            if (last) { __builtin_amdgcn_fence(__ATOMIC_ACQUIRE, "agent"); asm volatile("s_waitcnt vmcnt(0)" ::: "memory"); }
            *(LAS unsigned*)(lds + SM_FLAG + 4) = last;
        }
        __syncthreads();
        if (*(LAS unsigned*)(lds + SM_FLAG + 4)) {
            attn_finalize<false>(PO, PL, nsh, 2 * 64 * 128, 128, 128, lam, p.subln_g, 0.8f, SZA, OAN, qrow0, h);
        }
    }
}

__device__ __forceinline__ void ret_item(const Params& p, LAS unsigned char* lds, bool samp, int b, int h, int grp) {
    const int tid = opaque_tid(), wid = tid >> 6, lane = tid & 63, r = lane & 31, hh = lane >> 5, dvb = 32 * wid;
    LAS unsigned char* Qs = lds; LAS unsigned char* Ks = lds + 17408; LAS unsigned char* Kt = lds + 34816; LAS unsigned char* Vt = lds + 53248;
    const int pr = pi32(r);
    LAS float* Ost = (LAS float*)lds;
    const bf16_t* QB = (const bf16_t*)(p.ws + W_QB); const bf16_t* KB = (const bf16_t*)(p.ws + W_KB);
    const bf16_t* KBT = (const bf16_t*)(p.ws + W_KBT); const bf16_t* VBT = (const bf16_t*)(p.ws + W_VBT);
    const bf16_t* SZB = (const bf16_t*)(p.ws + W_SZB); bf16_t* OBN = (bf16_t*)(p.ws + W_OBN);
    const float lg0 = log2_gamma(h), g64 = fexp2(64.0f * lg0);
    const int bh = b * 4 + h;
    f32x16 R[4];
    if (samp) {
        const float* sr = p.state_ret + (size_t)bh * 128 * 128;
#pragma unroll
        for (int di = 0; di < 4; ++di)
#pragma unroll
            for (int g = 0; g < 16; ++g) R[di][g] = sr[(32 * di + prow(g, hh)) * 128 + dvb + r];
    } else {
#pragma unroll
        for (int di = 0; di < 4; ++di)
#pragma unroll
            for (int g = 0; g < 16; ++g) R[di][g] = 0.f;
    }
    const int n0 = samp ? 0 : GC * grp, n1 = samp ? 1 : GC * grp + GC, rowbase = samp ? MP + b * 64 : b * 2048, tstr = samp ? 64 : 2048;
    const size_t tbase = samp ? TSAMP + (size_t)bh * 128 * 64 : (size_t)bh * 128 * 2048;
    for (int n = n0; n < n1; ++n) {
        __syncthreads();
        {
            const bf16_t* qp = QB + (size_t)(rowbase + 64 * n) * 512 + h * 128; const bf16_t* kp = KB + (size_t)(rowbase + 64 * n) * 512 + h * 128;
            const bf16_t* ktp = KBT + tbase + 64 * n; const bf16_t* vtp = VBT + tbase + 64 * n;
            u32x4 wq[4], wk[4], wkt[4], wvt[4];
#pragma unroll
            for (int i = 0; i < 4; ++i) { wq[i] = *(const u32x4*)(qp + (size_t)((tid >> 4) + 16 * i) * 512 + (tid & 15) * 8); wk[i] = *(const u32x4*)(kp + (size_t)((tid >> 4) + 16 * i) * 512 + (tid & 15) * 8); }
#pragma unroll
            for (int i = 0; i < 4; ++i) { wkt[i] = *(const u32x4*)(ktp + (size_t)((tid >> 3) + 32 * i) * tstr + (tid & 7) * 8); wvt[i] = *(const u32x4*)(vtp + (size_t)((tid >> 3) + 32 * i) * tstr + (tid & 7) * 8); }
#pragma unroll
            for (int i = 0; i < 4; ++i) { *(LAS u32x4*)(Qs + ((tid >> 4) + 16 * i) * KS_STR + (tid & 15) * 16) = wq[i]; *(LAS u32x4*)(Ks + ((tid >> 4) + 16 * i) * KS_STR + (tid & 15) * 16) = wk[i]; }
#pragma unroll
            for (int i = 0; i < 4; ++i) { *(LAS u32x4*)(Kt + ((tid >> 3) + 32 * i) * VT_STR + (tid & 7) * 16) = wkt[i]; *(LAS u32x4*)(Vt + ((tid >> 3) + 32 * i) * VT_STR + (tid & 7) * 16) = wvt[i]; }
        }
        __syncthreads();
        float lg = lg0; int hv = hh, rv = r; asm volatile("" : "+v"(lg), "+v"(hv), "+v"(rv));
        const float xb = (float)(4 * hv + 1), db = (float)(rv - 8 * hv);
        f32x16 o[2];
#pragma unroll
        for (int ti = 0; ti < 2; ++ti) {
            f32x16 acc;
#pragma unroll
            for (int g = 0; g < 16; ++g) acc[g] = 0.f;
            bf16x8 qf[8];
#pragma unroll
            for (int kk = 0; kk < 8; ++kk) qf[kk] = lds_rd16(Qs + (32 * ti + r) * KS_STR + (16 * kk + 8 * hh) * 2);
#pragma unroll
            for (int di = 0; di < 4; ++di)
#pragma unroll
                for (int st = 0; st < 2; ++st) acc = mfma32(qf[2 * di + st], pack8(R[di], st), acc);
#pragma unroll
            for (int g = 0; g < 16; ++g) acc[g] *= fexp2((xb + (float)(32 * ti + (g & 3) + 8 * (g >> 2))) * lg);
            __builtin_amdgcn_sched_barrier(0);
#pragma unroll
            for (int si = 0; si < 2; ++si) {
                f32x16 s;
#pragma unroll
                for (int g = 0; g < 16; ++g) s[g] = 0.f;
#pragma unroll
                for (int kk = 0; kk < 8; ++kk) {
                    const bf16x8 kf = lds_rd16(Ks + (32 * si + pr) * KS_STR + (16 * kk + 8 * hh) * 2);
                    s = mfma32(kf, qf[kk], s);
                }
#pragma unroll
                for (int g = 0; g < 16; ++g) s[g] *= fexp2(fabsf(db + (float)(32 * ti - 32 * si - (g & 3) - 4 * ((g >> 2) & 1) - 16 * (g >> 3))) * lg);
#pragma unroll
                for (int st = 0; st < 2; ++st) {
                    const bf16x8 ap = pack8(s, st);
                    const bf16x8 vf = lds_rd16(Vt + (dvb + r) * VT_STR + (32 * si + 16 * st + 8 * hh) * 2);
                    acc = mfma32(ap, vf, acc);
                }
                __builtin_amdgcn_sched_barrier(0);
            }
            o[ti] = acc;
        }
#pragma unroll
        for (int di = 0; di < 4; ++di) {
#pragma unroll
            for (int g = 0; g < 16; ++g) R[di][g] *= g64;
#pragma unroll
            for (int kk = 0; kk < 4; ++kk) {
                const bf16x8 af = lds_rd16(Kt + (32 * di + pr) * VT_STR + (16 * kk + 8 * hh) * 2);
                const bf16x8 vf = lds_rd16(Vt + (dvb + r) * VT_STR + (16 * kk + 8 * hh) * 2);
                R[di] = mfma32(af, vf, R[di]);
            }
        }
        __syncthreads();
#pragma unroll
        for (int ti = 0; ti < 2; ++ti)
#pragma unroll
            for (int g = 0; g < 16; ++g) Ost[(32 * ti + accrow(g, hh)) * OX_STR + dvb + r] = o[ti][g];
        __syncthreads();
        if (!samp) {
            const int t = tid >> 2, q = tid & 3;
            float* op = (float*)(p.ws + W_OP) + (size_t)(rowbase + 64 * n + t) * 512 + h * 128 + q * 32;
#pragma unroll
            for (int i = 0; i < 8; ++i) *(f32x4*)(op + 4 * i) = *(const LAS f32x4*)(Ost + t * OX_STR + q * 32 + 4 * i);
        } else {
            const int t = tid >> 2, q = tid & 3; f32x4 a[8]; float ss = 0.f;
#pragma unroll
            for (int i = 0; i < 8; ++i) { a[i] = *(const LAS f32x4*)(Ost + t * OX_STR + q * 32 + 4 * i); ss += a[i][0] * a[i][0] + a[i][1] * a[i][1] + a[i][2] * a[i][2] + a[i][3] * a[i][3]; }
            ss += __shfl_xor(ss, 1); ss += __shfl_xor(ss, 2);
            const float inv = rsqrtf(ss * (1.0f / 128.0f) + EPS);
            const size_t base = (size_t)(rowbase + 64 * n + t) * 512 + h * 128 + q * 32;
            u32x4 zz[4];
#pragma unroll
            for (int i = 0; i < 4; ++i) zz[i] = *(const u32x4*)(SZB + base + 8 * i);
            __builtin_amdgcn_sched_barrier(0);
#pragma unroll
            for (int i = 0; i < 4; ++i) {
                const u32x4 z = zz[i]; const f32x4 x0 = a[2 * i], x1 = a[2 * i + 1]; u32x4 w;
                w.x = cvt_pk_bf16(x0[0] * inv * bflo(z.x), x0[1] * inv * bfhi(z.x)); w.y = cvt_pk_bf16(x0[2] * inv * bflo(z.y), x0[3] * inv * bfhi(z.y));
                w.z = cvt_pk_bf16(x1[0] * inv * bflo(z.z), x1[1] * inv * bfhi(z.z)); w.w = cvt_pk_bf16(x1[2] * inv * bflo(z.w), x1[3] * inv * bfhi(z.w));
                *(u32x4*)(OBN + base + 8 * i) = w;
            }
        }
    }
    float* ro = samp ? p.out + O_RS + (size_t)bh * 128 * 128 : (float*)(p.ws + W_UG) + (size_t)(bh * NG + grp) * 128 * 128;
#pragma unroll
    for (int di = 0; di < 4; ++di)
#pragma unroll
        for (int g = 0; g < 16; ++g) ro[(32 * di + prow(g, hh)) * 128 + dvb + r] = R[di][g];
}

__device__ __forceinline__ void ret_fix_item(const Params& p, LAS unsigned char* lds, int bh, int grp, int c) {
    const int tid = opaque_tid(), wid = tid >> 6, lane = tid & 63, r = lane & 31, hh = lane >> 5, dvb = 32 * wid;
    const int b = bh >> 2, h = bh & 3;
    LAS float* Ost = (LAS float*)lds;
    const bf16_t* QB = (const bf16_t*)(p.ws + W_QB); const bf16_t* SZB = (const bf16_t*)(p.ws + W_SZB); bf16_t* OBN = (bf16_t*)(p.ws + W_OBN);
    const float* UG = (const float*)(p.ws + W_UG) + (size_t)bh * NG * 16384;
    const float* OP = (const float*)(p.ws + W_OP);
    const float lg = log2_gamma(h), g256 = fexp2((float)(64 * GC) * lg);
    const int row0 = b * 2048 + 64 * (GC * grp + c);
    f32x16 o[2];
    if (grp > 0) {
        float R0[64];
#pragma unroll
        for (int i = 0; i < 64; ++i) R0[i] = 0.f;
        for (int gp = 0; gp < grp; gp += 2) {
            const bool two = gp + 1 < grp;
            const float* u0 = UG + (size_t)gp * 16384 + (8 * hh) * 128 + dvb + r;
            const float* u1 = UG + (size_t)(two ? gp + 1 : gp) * 16384 + (8 * hh) * 128 + dvb + r;
            const float w1 = two ? 1.0f : 0.0f, w0 = two ? g256 : 1.0f, wr0 = two ? g256 * g256 : g256;
#pragma unroll
            for (int hf = 0; hf < 2; ++hf) {
                float ta[32], tb[32];
#pragma unroll
                for (int i = 0; i < 32; ++i) { ta[i] = u0[(16 * ((32 * hf + i) >> 3) + (i & 7)) * 128]; tb[i] = u1[(16 * ((32 * hf + i) >> 3) + (i & 7)) * 128]; }
                __builtin_amdgcn_sched_barrier(0);
#pragma unroll
                for (int i = 0; i < 32; ++i) R0[32 * hf + i] = R0[32 * hf + i] * wr0 + ta[i] * w0 + tb[i] * w1;
                __builtin_amdgcn_sched_barrier(0);
            }
        }
        if (grp == NG - 1 && c == GC - 1) {
            const float* u = UG + (size_t)(NG - 1) * 16384 + (8 * hh) * 128 + dvb + r;
            float* ro = p.out + O_RP + (size_t)bh * 16384 + (8 * hh) * 128 + dvb + r;
#pragma unroll
            for (int hf = 0; hf < 2; ++hf) {
                float tu[32];
#pragma unroll
                for (int i = 0; i < 32; ++i) tu[i] = u[(16 * ((32 * hf + i) >> 3) + (i & 7)) * 128];
                __builtin_amdgcn_sched_barrier(0);
#pragma unroll
                for (int i = 0; i < 32; ++i) ro[(16 * ((32 * hf + i) >> 3) + (i & 7)) * 128] = R0[32 * hf + i] * g256 + tu[i];
                __builtin_amdgcn_sched_barrier(0);
            }
        }
        bf16x8 rf[8];
#pragma unroll
        for (int kk = 0; kk < 8; ++kk) {
            u32x4 w; w.x = cvt_pk_bf16(R0[8 * kk + 0], R0[8 * kk + 1]); w.y = cvt_pk_bf16(R0[8 * kk + 2], R0[8 * kk + 3]);
            w.z = cvt_pk_bf16(R0[8 * kk + 4], R0[8 * kk + 5]); w.w = cvt_pk_bf16(R0[8 * kk + 6], R0[8 * kk + 7]);
            rf[kk] = __builtin_bit_cast(bf16x8, w);
        }
#pragma unroll
        for (int ti = 0; ti < 2; ++ti) {
            f32x16 acc;
#pragma unroll
            for (int g = 0; g < 16; ++g) acc[g] = 0.f;
            const bf16_t* qp = QB + (size_t)(row0 + 32 * ti + r) * 512 + h * 128 + 8 * hh;
            bf16x8 qf[8];
#pragma unroll
            for (int kk = 0; kk < 8; ++kk) qf[kk] = *(const bf16x8*)(qp + 16 * kk);
            __builtin_amdgcn_sched_barrier(0);
#pragma unroll
            for (int kk = 0; kk < 8; ++kk) acc = mfma32(qf[kk], rf[kk], acc);
#pragma unroll
            for (int g = 0; g < 16; ++g) acc[g] *= fexp2((float)(64 * c + 32 * ti + accrow(g, hh) + 1) * lg);
            o[ti] = acc;
        }
    } else {
#pragma unroll
        for (int ti = 0; ti < 2; ++ti)
#pragma unroll
            for (int g = 0; g < 16; ++g) o[ti][g] = 0.f;
    }
    __syncthreads();
#pragma unroll
    for (int ti = 0; ti < 2; ++ti)
#pragma unroll
        for (int g = 0; g < 16; ++g) Ost[(32 * ti + accrow(g, hh)) * OX_STR + dvb + r] = o[ti][g];
    __syncthreads();
    {
        const int t = tid >> 2, q = tid & 3; f32x4 a[8]; float ss = 0.f;
        const float* op = OP + (size_t)(row0 + t) * 512 + h * 128 + q * 32;
        const size_t base = (size_t)(row0 + t) * 512 + h * 128 + q * 32;
        f32x4 po[8]; u32x4 zz[4];
#pragma unroll
        for (int i = 0; i < 8; ++i) po[i] = *(const f32x4*)(op + 4 * i);
#pragma unroll
        for (int i = 0; i < 4; ++i) zz[i] = *(const u32x4*)(SZB + base + 8 * i);
        __builtin_amdgcn_sched_barrier(0);
#pragma unroll
        for (int i = 0; i < 8; ++i) { a[i] = *(const LAS f32x4*)(Ost + t * OX_STR + q * 32 + 4 * i) + po[i]; ss += a[i][0] * a[i][0] + a[i][1] * a[i][1] + a[i][2] * a[i][2] + a[i][3] * a[i][3]; }
        ss += __shfl_xor(ss, 1); ss += __shfl_xor(ss, 2);
        const float inv = rsqrtf(ss * (1.0f / 128.0f) + EPS);
#pragma unroll
        for (int i = 0; i < 4; ++i) {
            const u32x4 z = zz[i]; const f32x4 x0 = a[2 * i], x1 = a[2 * i + 1]; u32x4 w;
            w.x = cvt_pk_bf16(x0[0] * inv * bflo(z.x), x0[1] * inv * bfhi(z.x)); w.y = cvt_pk_bf16(x0[2] * inv * bflo(z.y), x0[3] * inv * bfhi(z.y));
            w.z = cvt_pk_bf16(x1[0] * inv * bflo(z.z), x1[1] * inv * bfhi(z.z)); w.w = cvt_pk_bf16(x1[2] * inv * bflo(z.w), x1[3] * inv * bfhi(z.w));
            *(u32x4*)(OBN + base + 8 * i) = w;
        }
    }
}
__device__ void phase2b(const Params& p, LAS unsigned char* lds) {
    if (blockIdx.x < 32) {
        const int pm = 128 + (blockIdx.x >> 3), pn = blockIdx.x & 7;
        unsigned* c3 = (unsigned*)(p.ws + W_CTR) + 56 + (blockIdx.x >> 3);
        p3a_tile<true>(p, lds, pm, pn);
        asm volatile("s_waitcnt vmcnt(0)" ::: "memory");
        __syncthreads();
        if (threadIdx.x == 0) {
            __hip_atomic_fetch_add(c3, 1u, __ATOMIC_RELAXED, __HIP_MEMORY_SCOPE_AGENT);
            while (__hip_atomic_load(c3, __ATOMIC_RELAXED, __HIP_MEMORY_SCOPE_AGENT) < 8u) __builtin_amdgcn_s_sleep(2);
            __builtin_amdgcn_fence(__ATOMIC_ACQUIRE, "agent");
            asm volatile("s_waitcnt vmcnt(0)" ::: "memory");
        }
        __syncthreads();
        p3b_tile(p, lds, pm, pn);
        return;
    }
    const int nb = gridDim.x - 32;
    for (int it = blockIdx.x - 32; it < 1024; it += nb) ret_fix_item(p, lds, it & 31, it < 512 ? (NG - 1) - ((it >> 5) & (NG - 1)) : ((it >> 5) & (NG - 1)), (it >> 7) & (GC - 1));
}

constexpr int NRET = 32 * NG + 32;
constexpr int NITEMS = NRET + 32 * NSPLIT + 1024;
__device__ void phase2(const Params& p, LAS unsigned char* lds) {
    unsigned* ctr = (unsigned*)(p.ws + W_CTR);
    for (;;) {
        __syncthreads();
        if (threadIdx.x == 0) *(LAS int*)(lds + SM_FLAG) = (int)atomicAdd(ctr + 32, 1u);
        __syncthreads();
        const int it = *(LAS int*)(lds + SM_FLAG);
        if (it >= NITEMS) break;
        if (it < NRET) { const bool samp = it >= 32 * NG; const int bh = samp ? it - 32 * NG : it / NG; ret_item(p, lds, samp, bh >> 2, bh & 3, it % NG); }
        else {
            bool samp; int bh, idx;
            if (it < NRET + 32 * NSPLIT) { samp = true; const int kk = it - NRET, bb = kk / 24, s = kk % 24, hs = s < 2 ? 0 : s < 6 ? 1 : s < 15 ? 2 : 3; bh = bb * 4 + hs; idx = s - slot_of(hs); }
            else { samp = false; const int k = it - NRET - 32 * NSPLIT; idx = 31 - (k >> 5); bh = k & 31; }
            attn_item(p, lds, samp, bh >> 2, bh & 3, idx);
        }
    }
}

#define XB_TMO      128
#define XB_XCNT(j)  (256  + 64 * (j))
#define XB_XSUB(j)  (1280 + 64 * (j))
#define XB_XGEN(j)  (2304 + 64 * (j))
#define XB_TOP      3328
#define XB_TOPGEN   3392
#define XCD_BAR_WORDS 3456
#define XB_SPIN_CAP (1u << 18)

__device__ __forceinline__ unsigned xb_ld(unsigned* p)              { return __hip_atomic_load(p, __ATOMIC_RELAXED, __HIP_MEMORY_SCOPE_AGENT); }
__device__ __forceinline__ unsigned xb_add(unsigned* p, unsigned v) { return __hip_atomic_fetch_add(p, v, __ATOMIC_RELAXED, __HIP_MEMORY_SCOPE_AGENT); }
__device__ __forceinline__ unsigned xb_xcc_id() { return (unsigned)__builtin_amdgcn_s_getreg((3 << 11) | 20) & 0xFu; }
#define XB_SPIN(cond, bar) do { unsigned _sp = 0; while (cond) { __builtin_amdgcn_s_sleep(1); \
    if ((++_sp & 255u) == 0u) { if (xb_ld(&(bar)[XB_TMO])) break; if (_sp > XB_SPIN_CAP) { atomicAdd(&(bar)[XB_TMO], 1u); break; } } } } while (0)

struct XcdBarrier {
    unsigned* bar; unsigned x;
    volatile LAS unsigned* st;
};

__device__ __forceinline__ XcdBarrier xcd_barrier_post(unsigned* bar, volatile LAS unsigned* st) {
    XcdBarrier b; b.bar = bar; b.x = xb_xcc_id(); b.st = st;
    if (threadIdx.x == 0) (void)xb_add(&bar[XB_XCNT(b.x)], 1u);
    return b;
}
__device__ __forceinline__ void xcd_barrier_complete(unsigned* bar, unsigned x, unsigned& nloc, unsigned& nx) {
    const unsigned G = gridDim.x * gridDim.y * gridDim.z;
    unsigned sum, cnt, mine, sp = 0u;
    for (;;) {
        sum = 0u; cnt = 0u; mine = 0u;
#pragma unroll
        for (unsigned j = 0; j < 16; ++j) { const unsigned c = xb_ld(&bar[XB_XCNT(j)]); sum += c; cnt += (c > 0u) ? 1u : 0u; mine = (j == x) ? c : mine; }
        if (sum == G) break;
        __builtin_amdgcn_s_sleep(1);
        if ((++sp & 255u) == 0u) { if (xb_ld(&bar[XB_TMO])) break; if (sp > XB_SPIN_CAP) { atomicAdd(&bar[XB_TMO], 1u); break; } }
    }
    nloc = mine > 0u ? mine : 1u; nx = cnt > 0u ? cnt : 1u;
}

__device__ __forceinline__ void xcd_barrier(const XcdBarrier& b) {
    asm volatile("s_waitcnt vmcnt(0)" ::: "memory");
    __syncthreads();
    if (threadIdx.x == 0) {
        unsigned* bar = b.bar;
        __builtin_amdgcn_s_waitcnt(0);
        unsigned nloc = b.st[0], nx = b.st[1];
        if (nloc == 0u) { xcd_barrier_complete(bar, b.x, nloc, nx); b.st[0] = nloc; b.st[1] = nx; }
        const unsigned old = xb_add(&bar[XB_XSUB(b.x)], 1u);
        const unsigned gen = old / nloc;
        if (old + 1u == (gen + 1u) * nloc) {
            __builtin_amdgcn_fence(__ATOMIC_RELEASE, "agent");
            asm volatile("s_waitcnt vmcnt(0)" ::: "memory");
            const unsigned og = xb_add(&bar[XB_TOP], 1u);
            const unsigned tg = og / nx;
            if (og + 1u == (tg + 1u) * nx) xb_add(&bar[XB_TOPGEN], 1u);
            else XB_SPIN(xb_ld(&bar[XB_TOPGEN]) == tg, bar);
            __builtin_amdgcn_fence(__ATOMIC_ACQUIRE, "agent");
            xb_add(&bar[XB_XGEN(b.x)], 1u);
            asm volatile("s_waitcnt vmcnt(0)" ::: "memory");
        } else {
            XB_SPIN(xb_ld(&bar[XB_XGEN(b.x)]) == gen, bar);
            __builtin_amdgcn_fence(__ATOMIC_ACQUIRE, "agent");
            asm volatile("s_waitcnt vmcnt(0)" ::: "memory");
        }
    }
    __syncthreads();
}


__global__ void __launch_bounds__(256, 2) hybrid_fwd(Params p, int ph_lo, int ph_hi) {
    __shared__ __attribute__((aligned(16))) unsigned char smem[SMEM];
    LAS unsigned char* lds = (LAS unsigned char*)smem;
    cg::grid_group grid = cg::this_grid();
    if (threadIdx.x < 2) *(LAS unsigned*)(lds + SM_FLAG + 16 + 4 * threadIdx.x) = 0u;
    __syncthreads();
    const XcdBarrier xb = xcd_barrier_post((unsigned*)(p.ws + W_BAR), (volatile LAS unsigned*)(lds + SM_FLAG + 16));
#define RUN_PHASE(k, call) if (ph_lo <= (k) && (k) <= ph_hi) { call; if ((k) < ph_hi) { if (ph_hi > 1000) grid.sync(); else xcd_barrier(xb); } }
    RUN_PHASE(0, phase0(p, lds))
    RUN_PHASE(1, phase1(p, lds))
    RUN_PHASE(2, phase2(p, lds))
    RUN_PHASE(3, phase2b(p, lds))
    RUN_PHASE(4, phase3a(p, lds))
    RUN_PHASE(5, phase3b(p, lds))
#undef RUN_PHASE
}

extern "C" void kernel_launch(void* const* d_in, const int* in_sizes, int n_in, void* d_out, int out_size, void* d_ws, size_t ws_size, hipStream_t stream) {
    (void)in_sizes; (void)n_in; (void)out_size;
    static int grid_blocks = 0;
    if (!grid_blocks) {
        int dev = 0, cus = 0, per_cu = 0;
        hipGetDevice(&dev);
        hipDeviceGetAttribute(&cus, hipDeviceAttributeMultiprocessorCount, dev);
        hipOccupancyMaxActiveBlocksPerMultiprocessor(&per_cu, hybrid_fwd, 256, 0);
        if (per_cu > 2) per_cu = 2;
        if (per_cu < 1) per_cu = 1;
        grid_blocks = cus * per_cu;
    }
    if (ws_size < W_END) { fprintf(stderr, "workspace too small: %zu < %zu\n", ws_size, (size_t)W_END); return; }
    Params p{};
    p.x_prompt = (const float*)d_in[0]; p.x_sample = (const float*)d_in[1]; p.cache_k = (const float*)d_in[2]; p.cache_v = (const float*)d_in[3];
    p.state_ret = (const float*)d_in[4]; p.norm_g = (const float*)d_in[5]; p.w_in = (const float*)d_in[6]; p.b_gate = (const float*)d_in[7];
    p.qn_g = (const float*)d_in[8]; p.kn_g = (const float*)d_in[9]; p.lam_q1 = (const float*)d_in[10]; p.lam_k1 = (const float*)d_in[11];
    p.lam_q2 = (const float*)d_in[12]; p.lam_k2 = (const float*)d_in[13]; p.subln_g = (const float*)d_in[14]; p.w_oa = (const float*)d_in[15];
    p.w_ob = (const float*)d_in[16]; p.w_out = (const float*)d_in[17];
    p.out = (float*)d_out; p.ws = (unsigned char*)d_ws;
    hipMemsetAsync((unsigned char*)d_ws + W_BAR, 0, 3456 * 4, stream);
    int lo = 0, hi = 5;
    void* args[] = {&p, &lo, &hi};
    hipError_t e = hipLaunchCooperativeKernel((void*)hybrid_fwd, dim3(grid_blocks), dim3(256), args, 0, stream);
    if (e != hipSuccess) fprintf(stderr, "cooperative launch failed: %s (grid %d)\n", hipGetErrorString(e), grid_blocks);
}
```

```cpp
#include <hip/hip_runtime.h>
#include <hip/hip_cooperative_groups.h>
#include <cstdio>
#include <cstdint>
namespace cg = cooperative_groups;

#define LAS __attribute__((address_space(3)))
typedef unsigned short bf16_t;
typedef short bf16x8 __attribute__((ext_vector_type(8)));
typedef float f32x4 __attribute__((ext_vector_type(4)));
typedef float f32x16 __attribute__((ext_vector_type(16)));
typedef unsigned u32x4 __attribute__((ext_vector_type(4)));
typedef unsigned u32x2 __attribute__((ext_vector_type(2)));

constexpr int DM = 1024, SEQ = 2048, PAST = 4096;
constexpr int MP = 8 * SEQ, MS = 8 * 64, MT = MP + MS;
constexpr int WIN = 6144;
constexpr float EPS = 1e-6f;
constexpr float LOG2E = 1.4426950408889634f;
constexpr int GC = 8, NG = 32 / GC;
constexpr int NSPLIT = 6;
__host__ __device__ constexpr int nsplit_of(int h) { return h == 0 ? 2 : h == 1 ? 4 : 9; }
__host__ __device__ constexpr int slot_of(int h) { return h == 0 ? 0 : h == 1 ? 2 : h == 2 ? 6 : 15; }

constexpr size_t O_YP = 0, O_YS = 16777216, O_KP = 17301504, O_VP = 25690112, O_RP = 34078720, O_KS = 34603008, O_VS = 34865152, O_RS = 35127296;

constexpr size_t SZ_H = (size_t)MT * 512 * 2;
constexpr size_t W_XN = 0;
constexpr size_t W_OAN = 0, W_OBN = SZ_H;
constexpr size_t W_RSTD = 2 * SZ_H;
constexpr size_t W_WINT = W_RSTD + 67584;
constexpr size_t W_WOAT = W_WINT + (size_t)6144 * 1024 * 2;
constexpr size_t W_WOBT = W_WOAT + 1048576;
constexpr size_t W_WOUTT = W_WOBT + 1048576;
constexpr size_t W_QA = W_WOUTT + 2097152;
constexpr size_t W_KA = W_QA + SZ_H;
constexpr size_t W_MB = W_QA;
constexpr size_t W_VAT = W_KA + SZ_H;
constexpr size_t W_SZA = W_VAT + SZ_H;
constexpr size_t W_QB = W_SZA + SZ_H;
constexpr size_t W_KB = W_QB + SZ_H;
constexpr size_t W_KBT = W_KB + SZ_H;
constexpr size_t W_VBT = W_KBT + SZ_H;
constexpr size_t W_SZB = W_VBT + SZ_H;
constexpr size_t W_GAS = W_SZB + SZ_H;
constexpr size_t W_GBS = W_GAS + 1048576;
constexpr size_t W_PO = W_WINT;
constexpr size_t W_PL = W_GBS + 1048576;
constexpr size_t W_CTR = W_PL + (size_t)32 * NSPLIT * 2 * 64 * 4;
constexpr size_t W_BAR = W_CTR + 256;
constexpr size_t W_OP = W_BAR + 3456 * 4;
constexpr size_t W_UG = W_OP + (size_t)MP * 512 * 4;
constexpr size_t W_END = W_UG + (size_t)32 * 8 * 128 * 128 * 4;
static_assert((size_t)32 * NSPLIT * 2 * 64 * 128 * 4 <= (size_t)6144 * 1024 * 2, "split partials must fit the WinT region");
static_assert(W_END <= (size_t)268435456, "workspace map exceeds 256 MiB");
constexpr size_t TSAMP = (size_t)8 * 4 * 128 * 2048;

constexpr int SMEM = 72192;
constexpr int SM_FLAG = 71680;

struct Params {
    const float *x_prompt, *x_sample, *cache_k, *cache_v, *state_ret, *norm_g, *w_in, *b_gate, *qn_g, *kn_g;
    const float *lam_q1, *lam_k1, *lam_q2, *lam_k2, *subln_g, *w_oa, *w_ob, *w_out;
    float* out;
    unsigned char* ws;
};

typedef float f32x2 __attribute__((ext_vector_type(2)));
typedef __bf16 bf16x2n __attribute__((ext_vector_type(2)));
__device__ __forceinline__ unsigned cvt_pk_bf16(float lo, float hi) { const f32x2 v = {lo, hi}; return __builtin_bit_cast(unsigned, __builtin_convertvector(v, bf16x2n)); }
__device__ __forceinline__ int opaque_tid() { int t = threadIdx.x; asm volatile("" : "+v"(t)); return t; }
__device__ __forceinline__ float bflo(unsigned u) { return __uint_as_float(u << 16); }
__device__ __forceinline__ float bfhi(unsigned u) { return __uint_as_float(u & 0xffff0000u); }
__device__ __forceinline__ bf16_t f2bf(float f) { return (bf16_t)(cvt_pk_bf16(f, 0.f) & 0xffffu); }
__device__ __forceinline__ float fexp2(float x) { return __builtin_amdgcn_exp2f(x); }
__device__ __forceinline__ float frcp(float x) { return __builtin_amdgcn_rcpf(x); }
__device__ __forceinline__ float sigmoidf_(float x) { return frcp(1.0f + fexp2(-LOG2E * x)); }
__device__ __forceinline__ f32x16 mfma32(bf16x8 a, bf16x8 b, f32x16 c) { return __builtin_amdgcn_mfma_f32_32x32x16_bf16(a, b, c, 0, 0, 0); }
__device__ __forceinline__ f32x4 mfma16(bf16x8 a, bf16x8 b, f32x4 c) { return __builtin_amdgcn_mfma_f32_16x16x32_bf16(a, b, c, 0, 0, 0); }
__device__ __forceinline__ bf16x8 pack8(const f32x16& s, int st) {
    u32x4 w;
    w.x = cvt_pk_bf16(s[8 * st + 0], s[8 * st + 1]); w.y = cvt_pk_bf16(s[8 * st + 2], s[8 * st + 3]);
    w.z = cvt_pk_bf16(s[8 * st + 4], s[8 * st + 5]); w.w = cvt_pk_bf16(s[8 * st + 6], s[8 * st + 7]);
    return __builtin_bit_cast(bf16x8, w);
}
__device__ __forceinline__ bf16x8 lds_rd16(const LAS unsigned char* p) { return *(const LAS bf16x8*)p; }
__device__ __forceinline__ bf16x8 lds_rd8x2(const LAS unsigned char* p) {
    u32x2 a = *(const LAS u32x2*)p, b = *(const LAS u32x2*)(p + 16);
    u32x4 w; w.x = a.x; w.y = a.y; w.z = b.x; w.w = b.y; return __builtin_bit_cast(bf16x8, w);
}
__device__ __forceinline__ bf16x8 lds_rd8c(const LAS unsigned char* p) {
    u32x2 a = *(const LAS u32x2*)p, b = *(const LAS u32x2*)(p + 8);
    u32x4 w; w.x = a.x; w.y = a.y; w.z = b.x; w.w = b.y; return __builtin_bit_cast(bf16x8, w);
}
__device__ __forceinline__ float log2_gamma(int h) { return log2f(1.0f - exp2f(-5.0f - (float)h)); }
__device__ __forceinline__ int accrow(int g, int hh) { return (g & 3) + 8 * (g >> 2) + 4 * hh; }
__device__ __forceinline__ int pi32(int r) { return (r & 19) | ((r & 4) << 1) | ((r & 8) >> 1); }
__device__ __forceinline__ int prow(int g, int hh) { return (g & 3) + 4 * ((g >> 2) & 1) + 8 * hh + 16 * (g >> 3); }

__device__ __forceinline__ int lds_byte(int r, int c) { const int st = (r >> 4) * 2 + (c >> 5), rr = r & 15, cc = c & 31, ob = rr * 64 + cc * 2; return st * 1024 + (ob ^ (((ob >> 9) & 1) << 5)); }
__device__ __forceinline__ void stage_rc(int b, int& R, int& C) { const int st = b / 1024, sb = b % 1024, swz = sb ^ (((sb >> 9) & 1) << 5); R = (st >> 1) * 16 + swz / 64; C = (st & 1) * 32 + (swz % 64) / 2; }

__device__ __forceinline__ void gemm_accum(f32x4 (&acc)[4][4], const bf16_t* __restrict__ A, int lda, const bf16_t* __restrict__ Bt, int ldb, int K, LAS unsigned char* lds) {
    const int tid = opaque_tid(), wid = __builtin_amdgcn_readfirstlane(tid >> 6), lane = tid & 63, wr = wid >> 1, wc = wid & 1, fr = lane & 15, fq = lane >> 4;
    unsigned offA[4], offB[4];
#pragma unroll
    for (int i = 0; i < 4; ++i) { const int R = (wid + 4 * i) * 8 + (lane >> 3), c = (lane & 7) ^ ((R >> 1) & 7); offA[i] = (unsigned)(R * lda + c * 8) * 2u; offB[i] = (unsigned)(R * ldb + c * 8) * 2u; }
    const int fo0 = fr * 128 + ((fq ^ (fr >> 1)) << 4), fo1 = fo0 ^ 64;
    const int aoff = wr * 8192, boff = 16384 + wc * 8192;
    const int nk = K >> 6;
    __syncthreads();
#define GEMM_STAGE(kt, buf) do { LAS unsigned char* la_ = lds + (buf) * 32768 + wid * 1024; \
        _Pragma("unroll") for (int i_ = 0; i_ < 4; ++i_) __builtin_amdgcn_global_load_lds((const unsigned*)((const char*)A + offA[i_] + (size_t)(kt) * 128), (LAS unsigned*)(la_ + i_ * 4096), 16, 0, 0); \
        _Pragma("unroll") for (int i_ = 0; i_ < 4; ++i_) __builtin_amdgcn_global_load_lds((const unsigned*)((const char*)Bt + offB[i_] + (size_t)(kt) * 128), (LAS unsigned*)(la_ + 16384 + i_ * 4096), 16, 0, 0); } while (0)
    GEMM_STAGE(0, 0);
    for (int kt = 0; kt < nk; ++kt) {
        asm volatile("s_waitcnt vmcnt(0)" ::: "memory");
        __syncthreads();
        if (kt + 1 < nk) GEMM_STAGE(kt + 1, (kt + 1) & 1);
        const LAS unsigned char* ps = lds + (kt & 1) * 32768;
        bf16x8 af[4][2], bfr[4][2];
#pragma unroll
        for (int m = 0; m < 4; ++m) { af[m][0] = lds_rd16(ps + aoff + m * 2048 + fo0); af[m][1] = lds_rd16(ps + aoff + m * 2048 + fo1); }
#pragma unroll
        for (int n = 0; n < 4; ++n) { bfr[n][0] = lds_rd16(ps + boff + n * 2048 + fo0); bfr[n][1] = lds_rd16(ps + boff + n * 2048 + fo1); }
#pragma unroll
        for (int kk = 0; kk < 2; ++kk)
#pragma unroll
            for (int m = 0; m < 4; ++m)
#pragma unroll
                for (int n = 0; n < 4; ++n) acc[m][n] = mfma16(bfr[n][kk], af[m][kk], acc[m][n]);
    }
#undef GEMM_STAGE
}
__device__ __forceinline__ void acc_zero(f32x4 (&acc)[4][4]) {
#pragma unroll
    for (int m = 0; m < 4; ++m)
#pragma unroll
        for (int n = 0; n < 4; ++n) acc[m][n] = (f32x4){0.f, 0.f, 0.f, 0.f};
}

__device__ void phase0(const Params& p, LAS unsigned char* lds) {
    const int tid = opaque_tid(), wid = tid >> 6, lane = tid & 63;
    bf16_t* XN = (bf16_t*)(p.ws + W_XN); float* RSTD = (float*)(p.ws + W_RSTD);
    if (blockIdx.x == 0) {
        unsigned* ctr = (unsigned*)(p.ws + W_CTR);
        if (tid < 40) ctr[tid] = 0u;
        if (tid >= 56 && tid < 60) ctr[tid] = 0u;
        if (wid == 1) {
            float a = p.lam_q1[lane] * p.lam_k1[lane], b = p.lam_q2[lane] * p.lam_k2[lane];
            float gq = fabsf(p.qn_g[lane]), gk = fabsf(p.kn_g[lane]);
#pragma unroll
            for (int o = 32; o >= 1; o >>= 1) { a += __shfl_xor(a, o); b += __shfl_xor(b, o); gq = fmaxf(gq, __shfl_xor(gq, o)); gk = fmaxf(gk, __shfl_xor(gk, o)); }
            if (lane == 0) { float* sc = (float*)(p.ws + W_CTR); sc[40] = expf(a) - expf(b) + 0.2f; sc[41] = 8.0f * gq * gk * LOG2E; }
        }
    }
    const int gw = blockIdx.x * 4 + wid, nw = gridDim.x * 4;
    for (int row = gw; row < MT; row += nw) {
        const float* xr = row < MP ? p.x_prompt + (size_t)row * DM : p.x_sample + (size_t)(row - MP) * DM;
        f32x4 v[4]; float ss = 0.f;
#pragma unroll
        for (int i = 0; i < 4; ++i) { v[i] = *(const f32x4*)(xr + i * 256 + lane * 4); ss += v[i][0] * v[i][0] + v[i][1] * v[i][1] + v[i][2] * v[i][2] + v[i][3] * v[i][3]; }
#pragma unroll
        for (int o = 32; o >= 1; o >>= 1) ss += __shfl_xor(ss, o);
        if (lane == 0) RSTD[row] = rsqrtf(ss * (1.0f / 1024.0f) + EPS);
        f32x4 gn[4];
#pragma unroll
        for (int i = 0; i < 4; ++i) gn[i] = *(const f32x4*)(p.norm_g + i * 256 + lane * 4);
#pragma unroll
        for (int i = 0; i < 4; ++i) { const f32x4 g = gn[i]; u32x2 w; w.x = cvt_pk_bf16(v[i][0] * g[0], v[i][1] * g[1]); w.y = cvt_pk_bf16(v[i][2] * g[2], v[i][3] * g[3]);
            *(u32x2*)(XN + (size_t)row * DM + i * 256 + lane * 4) = w; }
    }
    LAS float* tile = (LAS float*)lds;
    const int tx = tid & 63, ty = tid >> 6;
    for (int t = blockIdx.x; t < 2048; t += gridDim.x) {
        const float* src; bf16_t* dst; int K, N, tt;
        if (t < 1536) { src = p.w_in; dst = (bf16_t*)(p.ws + W_WINT); K = 1024; N = 6144; tt = t; }
        else if (t < 1664) { src = p.w_oa; dst = (bf16_t*)(p.ws + W_WOAT); K = 512; N = 1024; tt = t - 1536; }
        else if (t < 1792) { src = p.w_ob; dst = (bf16_t*)(p.ws + W_WOBT); K = 512; N = 1024; tt = t - 1664; }
        else { src = p.w_out; dst = (bf16_t*)(p.ws + W_WOUTT); K = 1024; N = 1024; tt = t - 1792; }
        const int ntn = N >> 6, k0 = (tt / ntn) * 64, n0 = (tt % ntn) * 64;
        __syncthreads();
        float tv[16];
#pragma unroll
        for (int i = 0; i < 16; ++i) tv[i] = src[(size_t)(k0 + ty + 4 * i) * N + n0 + tx];
#pragma unroll
        for (int i = 0; i < 16; ++i) tile[(ty + 4 * i) * 65 + tx] = tv[i];
        __syncthreads();
#pragma unroll
        for (int i = 0; i < 16; ++i) dst[(size_t)(n0 + ty + 4 * i) * K + k0 + tx] = f2bf(tile[tx * 65 + ty + 4 * i]);
    }
}

__device__ __forceinline__ void epi_inproj(const Params& p, f32x4 (&acc)[4][4], int pm, int pn, LAS unsigned char* lds) {
    const int tid = opaque_tid(), wid = tid >> 6, lane = tid & 63, wr = wid >> 1, wc = wid & 1, fr = lane & 15, fq = lane >> 4;
    const int colw = pn * 128 + wc * 64, seg = colw >> 9, c0 = (colw & 511) + fq * 4;
    const bool samp = pm * 128 >= MP;
    const float* RSTD = (const float*)(p.ws + W_RSTD);
    unsigned char* ws = p.ws;
    float rsv[4];
#pragma unroll
    for (int m = 0; m < 4; ++m) rsv[m] = RSTD[pm * 128 + wr * 64 + m * 16 + fr];
    f32x4 gv[4];
    {
        const float* gsrc = seg == 0 ? p.qn_g + (c0 & 63) : seg == 1 ? p.kn_g + (c0 & 63) : seg >= 8 ? p.b_gate + (seg >= 10 ? 1024 : 0) + colw - (seg >= 10 ? 5120 : 4096) + fq * 4 : p.qn_g;
#pragma unroll
        for (int n = 0; n < 4; ++n) gv[n] = *(const f32x4*)(gsrc + n * 16);
    }
    __builtin_amdgcn_sched_barrier(0);
    __syncthreads();
    LAS unsigned char* NT = lds; LAS unsigned char* TT = lds + 34816;
#pragma unroll
    for (int m = 0; m < 4; ++m) {
        const int r = pm * 128 + wr * 64 + m * 16 + fr;
        const int lrow = wr * 64 + m * 16 + fr, lcol = wc * 64 + fq * 4;
        const float rs = rsv[m];
        f32x4 v[4];
#pragma unroll
        for (int n = 0; n < 4; ++n) v[n] = acc[m][n] * rs;
        const int rl = samp ? r - MP : r;
        const int tb = samp ? (rl >> 6) : (rl >> 11), tt = samp ? (rl & 63) : (rl & 2047), tstr = samp ? 64 : 2048;
        const size_t tbase = (samp ? TSAMP : 0) + (size_t)tb * 4 * 128 * tstr + tt;
        if (seg <= 1) {
            float ss = 0.f;
#pragma unroll
            for (int n = 0; n < 4; ++n) ss += v[n][0] * v[n][0] + v[n][1] * v[n][1] + v[n][2] * v[n][2] + v[n][3] * v[n][3];
            ss += __shfl_xor(ss, 16); ss += __shfl_xor(ss, 32);
            const float inv = rsqrtf(ss * (1.0f / 64.0f) + EPS);
            const float sc = seg == 0 ? inv * (0.125f * LOG2E) : inv;
            float* dstf = p.out + (samp ? O_KS + (size_t)rl * 512 : O_KP + (size_t)rl * 512);
#pragma unroll
            for (int n = 0; n < 4; ++n) {
                const int c = c0 + n * 16; const f32x4 g = gv[n];
                f32x4 o; o[0] = v[n][0] * sc * g[0]; o[1] = v[n][1] * sc * g[1]; o[2] = v[n][2] * sc * g[2]; o[3] = v[n][3] * sc * g[3];
                u32x2 w; w.x = cvt_pk_bf16(o[0], o[1]); w.y = cvt_pk_bf16(o[2], o[3]);
                *(LAS u32x2*)(NT + lrow * 272 + (lcol + n * 16) * 2) = w;
                if (seg == 1) *(f32x4*)(dstf + c) = o;
            }
        } else if (seg == 2 || seg == 6) {
            float* dstf = p.out + (samp ? O_VS + (size_t)rl * 512 : O_VP + (size_t)rl * 512);
#pragma unroll
            for (int n = 0; n < 4; ++n) {
                const int c = c0 + n * 16;
                if (seg == 2) *(f32x4*)(dstf + c) = v[n];
#pragma unroll
                for (int j = 0; j < 4; ++j) *(LAS bf16_t*)(TT + (lcol + n * 16 + j) * 272 + lrow * 2) = f2bf(v[n][j]);
            }
        } else if (seg == 3 || seg == 7) {
#pragma unroll
            for (int n = 0; n < 4; ++n) {
                const int c = c0 + n * 16; f32x4 o;
#pragma unroll
                for (int j = 0; j < 4; ++j) o[j] = v[n][j] * sigmoidf_(v[n][j]);
                u32x2 w; w.x = cvt_pk_bf16(o[0], o[1]); w.y = cvt_pk_bf16(o[2], o[3]);
                *(LAS u32x2*)(NT + lrow * 272 + (lcol + n * 16) * 2) = w;
            }
        } else if (seg == 4) {
#pragma unroll
            for (int n = 0; n < 4; ++n) { u32x2 w; w.x = cvt_pk_bf16(v[n][0], v[n][1]); w.y = cvt_pk_bf16(v[n][2], v[n][3]); *(LAS u32x2*)(NT + lrow * 272 + (lcol + n * 16) * 2) = w; }
        } else if (seg == 5) {
            const int hh = c0 >> 7;
            const float zeta = fexp2((float)(63 - (r & 63)) * log2_gamma(hh));
            const float ksc = 0.08838834764831845f;
#pragma unroll
            for (int n = 0; n < 4; ++n) {
                const int c = c0 + n * 16; f32x4 o = v[n] * ksc;
                u32x2 w; w.x = cvt_pk_bf16(o[0], o[1]); w.y = cvt_pk_bf16(o[2], o[3]); *(LAS u32x2*)(NT + lrow * 272 + (lcol + n * 16) * 2) = w;
#pragma unroll
                for (int j = 0; j < 4; ++j) *(LAS bf16_t*)(TT + (lcol + n * 16 + j) * 272 + lrow * 2) = f2bf(o[j] * zeta);
            }
        } else {
#pragma unroll
            for (int n = 0; n < 4; ++n) {
                const float rs2 = -LOG2E * rs;
                const f32x4 b2 = gv[n] * (-LOG2E); f32x4 o;
#pragma unroll
                for (int j = 0; j < 4; ++j) o[j] = frcp(1.0f + fexp2(__builtin_fmaf(acc[m][n][j], rs2, b2[j])));
                u32x2 w; w.x = cvt_pk_bf16(o[0], o[1]); w.y = cvt_pk_bf16(o[2], o[3]); *(LAS u32x2*)(NT + lrow * 272 + (lcol + n * 16) * 2) = w;
            }
        }
    }
    __syncthreads();
    const int rl0 = pm * 128 - (samp ? MP : 0), ct = (pn * 128) & 511;
    if (seg != 2 && seg != 6) {
        bf16_t* dst; int ld;
        if (seg < 8) { const size_t wo = seg == 0 ? W_QA : seg == 1 ? W_KA : seg == 3 ? W_SZA : seg == 4 ? W_QB : seg == 5 ? W_KB : W_SZB; dst = (bf16_t*)(ws + wo) + (size_t)(pm * 128) * 512 + ct; ld = 512; }
        else { const int which = seg >= 10, cg = pn * 128 - (which ? 5120 : 4096);
               dst = (samp ? (bf16_t*)(ws + (which ? W_GBS : W_GAS)) : (bf16_t*)p.out + (which ? (size_t)MP * 1024 : 0)) + (size_t)rl0 * 1024 + cg; ld = 1024; }
        u32x4 tv[8];
#pragma unroll
        for (int i = 0; i < 8; ++i) { const int q = tid + 256 * i; tv[i] = *(const LAS u32x4*)(NT + (q >> 4) * 272 + (q & 15) * 16); }
#pragma unroll
        for (int i = 0; i < 8; ++i) { const int q = tid + 256 * i; *(u32x4*)(dst + (size_t)(q >> 4) * ld + (q & 15) * 8) = tv[i]; }
    }
    if (seg == 2 || seg == 5 || seg == 6) {
        bf16_t* dstt = (bf16_t*)(ws + (seg == 2 ? W_VAT : seg == 5 ? W_KBT : W_VBT));
        const int tstr = samp ? 64 : 2048;
        u32x4 tv[8];
#pragma unroll
        for (int i = 0; i < 8; ++i) { const int q = tid + 256 * i; tv[i] = *(const LAS u32x4*)(TT + (q >> 4) * 272 + (q & 15) * 16); }
#pragma unroll
        for (int i = 0; i < 8; ++i) {
            const int q = tid + 256 * i, cl = q >> 4, rl = rl0 + (q & 15) * 8;
            const size_t tb = samp ? TSAMP + (size_t)(rl >> 6) * 4 * 128 * 64 + (rl & 63) : (size_t)(rl >> 11) * 4 * 128 * 2048 + (rl & 2047);
            *(u32x4*)(dstt + tb + (size_t)(ct + cl) * tstr) = tv[i];
        }
    }
}

__device__ void phase1(const Params& p, LAS unsigned char* lds) {
    const bf16_t* XN = (const bf16_t*)(p.ws + W_XN); const bf16_t* WT = (const bf16_t*)(p.ws + W_WINT);
    constexpr int NSM = 17, NSN = 6, NSUP = NSM * NSN, NSLOT = ((NSUP + 7) / 8) * 8 * 64;
    for (int tile = blockIdx.x; tile < NSLOT; tile += gridDim.x) {
        const int xcd = tile & 7, q = tile >> 3, S = (q >> 6) * 8 + xcd, within = q & 63;
        if (S >= NSUP) continue;
        const int pm = (S % NSM) * 8 + (within & 7), pn = (S / NSM) * 8 + (within >> 3);
        if (pm >= 132) continue;
        f32x4 acc[4][4]; acc_zero(acc);
        gemm_accum(acc, XN + (size_t)pm * 128 * DM, DM, WT + (size_t)pn * 128 * DM, DM, DM, lds);
        epi_inproj(p, acc, pm, pn, lds);
    }
}

template <bool WT>
__device__ __forceinline__ void p3a_tile(const Params& p, LAS unsigned char* lds, int pm, int pn) {
    const int tid = opaque_tid(), wid = tid >> 6, lane = tid & 63, wr = wid >> 1, wc = wid & 1, fr = lane & 15, fq = lane >> 4;
    const bf16_t* OAN = (const bf16_t*)(p.ws + W_OAN); const bf16_t* OBN = (const bf16_t*)(p.ws + W_OBN);
    const bf16_t* WA = (const bf16_t*)(p.ws + W_WOAT); const bf16_t* WB = (const bf16_t*)(p.ws + W_WOBT);
    bf16_t* MB = (bf16_t*)(p.ws + W_MB);
    const bool samp = pm * 128 >= MP;
    f32x4 acc[4][4]; acc_zero(acc);
    gemm_accum(acc, OAN + (size_t)pm * 128 * 512, 512, WA + (size_t)pn * 128 * 512, 512, 512, lds);
    const int cbase = pn * 128 + wc * 64 + fq * 4;
#pragma unroll
    for (int m = 0; m < 4; ++m) {
        const int r = pm * 128 + wr * 64 + m * 16 + fr, rl = samp ? r - MP : r;
        const bf16_t* ga = samp ? (const bf16_t*)(p.ws + W_GAS) + (size_t)rl * 1024 : (const bf16_t*)p.out + (size_t)rl * 1024;
        const bf16_t* gb = samp ? (const bf16_t*)(p.ws + W_GBS) + (size_t)rl * 1024 : (const bf16_t*)p.out + (size_t)MP * 1024 + (size_t)rl * 1024;
        u32x2 av[4], bv[4];
#pragma unroll
        for (int n = 0; n < 4; ++n) { av[n] = *(const u32x2*)(ga + cbase + n * 16); bv[n] = *(const u32x2*)(gb + cbase + n * 16); }
        __builtin_amdgcn_sched_barrier(0);
#pragma unroll
        for (int n = 0; n < 4; ++n) {
            const u32x2 a = av[n], b = bv[n];
            acc[m][n][0] *= bflo(a.x) * frcp(bflo(b.x)); acc[m][n][1] *= bfhi(a.x) * frcp(bfhi(b.x)); acc[m][n][2] *= bflo(a.y) * frcp(bflo(b.y)); acc[m][n][3] *= bfhi(a.y) * frcp(bfhi(b.y));
        }
    }
    gemm_accum(acc, OBN + (size_t)pm * 128 * 512, 512, WB + (size_t)pn * 128 * 512, 512, 512, lds);
#pragma unroll
    for (int m = 0; m < 4; ++m) {
        const int r = pm * 128 + wr * 64 + m * 16 + fr, rl = samp ? r - MP : r;
        const bf16_t* gb = samp ? (const bf16_t*)(p.ws + W_GBS) + (size_t)rl * 1024 : (const bf16_t*)p.out + (size_t)MP * 1024 + (size_t)rl * 1024;
        u32x2 bv[4];
#pragma unroll
        for (int n = 0; n < 4; ++n) bv[n] = *(const u32x2*)(gb + cbase + n * 16);
        __builtin_amdgcn_sched_barrier(0);
#pragma unroll
        for (int n = 0; n < 4; ++n) {
            const u32x2 b = bv[n];
            u32x2 w; w.x = cvt_pk_bf16(acc[m][n][0] * bflo(b.x), acc[m][n][1] * bfhi(b.x)); w.y = cvt_pk_bf16(acc[m][n][2] * bflo(b.y), acc[m][n][3] * bfhi(b.y));
            if constexpr (WT) __hip_atomic_store((unsigned long long*)(MB + (size_t)r * 1024 + cbase + n * 16), ((unsigned long long)w.y << 32) | w.x, __ATOMIC_RELAXED, __HIP_MEMORY_SCOPE_AGENT);
            else *(u32x2*)(MB + (size_t)r * 1024 + cbase + n * 16) = w;
        }
    }
}
__device__ __forceinline__ void p3b_tile(const Params& p, LAS unsigned char* lds, int pm, int pn) {
    const int tid = opaque_tid(), wid = tid >> 6, lane = tid & 63, wr = wid >> 1, wc = wid & 1, fr = lane & 15, fq = lane >> 4;
    const bf16_t* MB = (const bf16_t*)(p.ws + W_MB); const bf16_t* WO = (const bf16_t*)(p.ws + W_WOUTT);
    const bool samp = pm * 128 >= MP;
    f32x4 acc[4][4]; acc_zero(acc);
    gemm_accum(acc, MB + (size_t)pm * 128 * 1024, 1024, WO + (size_t)pn * 128 * 1024, 1024, 1024, lds);
    const int cbase = pn * 128 + wc * 64 + fq * 4;
#pragma unroll
    for (int m = 0; m < 4; ++m) {
        const int r = pm * 128 + wr * 64 + m * 16 + fr, rl = samp ? r - MP : r;
        const float* xr = (samp ? p.x_sample : p.x_prompt) + (size_t)rl * 1024;
        float* yr = p.out + (samp ? O_YS : O_YP) + (size_t)rl * 1024;
        f32x4 xv[4];
#pragma unroll
        for (int n = 0; n < 4; ++n) xv[n] = *(const f32x4*)(xr + cbase + n * 16);
        __builtin_amdgcn_sched_barrier(0);
#pragma unroll
        for (int n = 0; n < 4; ++n) *(f32x4*)(yr + cbase + n * 16) = xv[n] + acc[m][n];
    }
}
__device__ void phase3a(const Params& p, LAS unsigned char* lds) {
    constexpr int NSUP = 32, NSLOT = NSUP * 32;
    for (int tile = blockIdx.x; tile < NSLOT; tile += gridDim.x) {
        const int xcd = tile & 7, q = tile >> 3, S = (q >> 5) * 8 + xcd, within = q & 31;
        p3a_tile<false>(p, lds, S * 4 + (within & 3), within >> 2);
    }
}
__device__ void phase3b(const Params& p, LAS unsigned char* lds) {
    constexpr int NSUP = 32, NSLOT = NSUP * 32;
    for (int tile = blockIdx.x; tile < NSLOT; tile += gridDim.x) {
        const int xcd = tile & 7, q = tile >> 3, S = (q >> 5) * 8 + xcd, within = q & 31;
        p3b_tile(p, lds, S * 4 + (within & 3), within >> 2);
    }
}

constexpr int KS_STR = 272, VT_STR = 144, OX_STR = 132;
template <bool INLDS>
__device__ __forceinline__ void attn_finalize(const float* O, const float* L, int nsplit, int sstrO, int sstrL, int ostr, float lam, const float* __restrict__ gain, float gscale,
                                              const bf16_t* __restrict__ sz, bf16_t* __restrict__ dst, int row0, int h) {
    const int tid = opaque_tid(), t = tid >> 2, q = tid & 3;
    float l0 = 0.f, l1 = 0.f; f32x4 a0[8], a1[8];
#pragma unroll
    for (int i = 0; i < 8; ++i) { a0[i] = (f32x4){0.f, 0.f, 0.f, 0.f}; a1[i] = (f32x4){0.f, 0.f, 0.f, 0.f}; }
    for (int s = 0; s < nsplit; ++s) {
        f32x4 t0[8], t1[8];
        if constexpr (INLDS) {
            const LAS float* Ll = (const LAS float*)L; const LAS float* o0 = (const LAS float*)O + t * ostr + q * 32; const LAS float* o1 = o0 + 64 * ostr;
            l0 += Ll[t]; l1 += Ll[64 + t];
#pragma unroll
            for (int i = 0; i < 8; ++i) { t0[i] = *(const LAS f32x4*)(o0 + 4 * i); t1[i] = *(const LAS f32x4*)(o1 + 4 * i); }
        } else {
            l0 += L[s * sstrL + t]; l1 += L[s * sstrL + 64 + t];
            const float* o0 = O + (size_t)s * sstrO + t * ostr + q * 32; const float* o1 = o0 + 64 * ostr;
#pragma unroll
            for (int i = 0; i < 8; ++i) { t0[i] = *(const f32x4*)(o0 + 4 * i); t1[i] = *(const f32x4*)(o1 + 4 * i); }
        }
        __builtin_amdgcn_sched_barrier(0);
#pragma unroll
        for (int i = 0; i < 8; ++i) { a0[i] += t0[i]; a1[i] += t1[i]; }
    }
    const float c0 = 1.0f / l0, c1 = lam / l1; float ss = 0.f;
#pragma unroll
    for (int i = 0; i < 8; ++i) { a0[i] = a0[i] * c0 - a1[i] * c1; ss += a0[i][0] * a0[i][0] + a0[i][1] * a0[i][1] + a0[i][2] * a0[i][2] + a0[i][3] * a0[i][3]; }
    ss += __shfl_xor(ss, 1); ss += __shfl_xor(ss, 2);
    const float inv = rsqrtf(ss * (1.0f / 128.0f) + EPS) * gscale;
    const size_t base = (size_t)(row0 + t) * 512 + h * 128 + q * 32;
    u32x4 zz[4]; f32x4 gg[8];
#pragma unroll
    for (int i = 0; i < 4; ++i) { zz[i] = *(const u32x4*)(sz + base + 8 * i); gg[2 * i] = *(const f32x4*)(gain + q * 32 + 8 * i); gg[2 * i + 1] = *(const f32x4*)(gain + q * 32 + 8 * i + 4); }
    __builtin_amdgcn_sched_barrier(0);
#pragma unroll
    for (int i = 0; i < 4; ++i) {
        const u32x4 z = zz[i];
        const f32x4 g0 = gg[2 * i], g1 = gg[2 * i + 1];
        const f32x4 x0 = a0[2 * i], x1 = a0[2 * i + 1]; u32x4 w;
        w.x = cvt_pk_bf16(x0[0] * inv * g0[0] * bflo(z.x), x0[1] * inv * g0[1] * bfhi(z.x));
        w.y = cvt_pk_bf16(x0[2] * inv * g0[2] * bflo(z.y), x0[3] * inv * g0[3] * bfhi(z.y));
        w.z = cvt_pk_bf16(x1[0] * inv * g1[0] * bflo(z.z), x1[1] * inv * g1[1] * bfhi(z.z));
        w.w = cvt_pk_bf16(x1[2] * inv * g1[2] * bflo(z.w), x1[3] * inv * g1[3] * bfhi(z.w));
        *(u32x4*)(dst + base + 8 * i) = w;
    }
}

__device__ __forceinline__ void attn_item(const Params& p, LAS unsigned char* lds, bool samp, int b, int h, int idx) {
    const int tid = opaque_tid(), wid = tid >> 6, lane = tid & 63, r = lane & 31, hh = lane >> 5, qh = wid & 1, c = wid >> 1;
    const bf16_t* QA = (const bf16_t*)(p.ws + W_QA); const bf16_t* KA = (const bf16_t*)(p.ws + W_KA); const bf16_t* VAT = (const bf16_t*)(p.ws + W_VAT);
    const float* scal = (const float*)(p.ws + W_CTR);
    const float lam = scal[40], C2 = scal[41];
    int qrow0, qpos0, j0, j1;
    if (!samp) { qrow0 = b * 2048 + 64 * idx; qpos0 = 64 * idx; const int Tp = (111 << (2 * h + 2)) + 63; j0 = qpos0 >= Tp ? ((qpos0 - Tp) >> 6) + 1 : 0; j1 = idx + 1; }
    else {
        const int Th = (111 << (2 * h + 2)) + 63;
        const int jmin = PAST >= Th ? ((PAST - Th) >> 6) + 1 : 0, nt = 65 - jmin;
        const int nsh = nsplit_of(h);
        qrow0 = MP + b * 64; qpos0 = PAST; j0 = jmin + idx * nt / nsh; j1 = jmin + (idx + 1) * nt / nsh;
    }
    bf16x8 qf[4];
    { const bf16_t* qp = QA + (size_t)(qrow0 + 32 * qh + r) * 512 + h * 128 + c * 64 + 8 * hh;
#pragma unroll
      for (int kk = 0; kk < 4; ++kk) qf[kk] = *(const bf16x8*)(qp + 16 * kk); }
    const float sl2 = exp2f(-2.0f * (float)(h + 1)) * LOG2E;
    const float qposh = (float)(qpos0 + 32 * qh + r - 8 * hh);
    f32x16 O[4];
#pragma unroll
    for (int dt = 0; dt < 4; ++dt)
#pragma unroll
        for (int g = 0; g < 16; ++g) O[dt][g] = 0.f;
    float lsum = 0.f;
    LAS unsigned char* Ks = lds; LAS unsigned char* Vt = lds + 17408;
    const int pr = pi32(r);
    u32x4 stg[16];
    const int tid_ = tid;
    auto issue = [&](int j) {
        int tid = tid_; asm volatile("" : "+v"(tid));
        if (samp && j < 64) {
            const float* kc = p.cache_k + (((size_t)b * PAST + 64 * j) * 4 + h) * 128;
            const float* vc = p.cache_v + (((size_t)b * PAST + 64 * j) * 4 + h) * 128;
            const int kg = tid >> 5, piece = tid & 31;
#pragma unroll
            for (int i = 0; i < 8; ++i) stg[i] = *(const u32x4*)(kc + (size_t)(kg + 8 * i) * 512 + piece * 4);
#pragma unroll
            for (int i = 0; i < 8; ++i) stg[8 + i] = *(const u32x4*)(vc + (size_t)(8 * kg + i) * 512 + piece * 4);
        } else {
            const int krow0 = samp ? MP + b * 64 : b * 2048 + 64 * j;
            const bf16_t* kp = KA + (size_t)krow0 * 512 + h * 128;
            const bf16_t* vp = samp ? VAT + TSAMP + (size_t)(b * 4 + h) * 128 * 64 : VAT + (size_t)(b * 4 + h) * 128 * 2048 + 64 * j;
            const int vstr = samp ? 64 : 2048;
#pragma unroll
            for (int i = 0; i < 4; ++i) stg[i] = *(const u32x4*)(kp + (size_t)((tid >> 4) + 16 * i) * 512 + (tid & 15) * 8);
#pragma unroll
            for (int i = 0; i < 4; ++i) stg[4 + i] = *(const u32x4*)(vp + (size_t)((tid >> 3) + 32 * i) * vstr + (tid & 7) * 8);
        }
    };
    auto commit = [&](int j, LAS unsigned char* Kd, LAS unsigned char* Vd) {
        int tid = tid_; asm volatile("" : "+v"(tid));
        if (samp && j < 64) {
            const int kg = tid >> 5, piece = tid & 31;
#pragma unroll
            for (int i = 0; i < 8; ++i) { u32x2 w; w.x = cvt_pk_bf16(__uint_as_float(stg[i].x), __uint_as_float(stg[i].y)); w.y = cvt_pk_bf16(__uint_as_float(stg[i].z), __uint_as_float(stg[i].w)); *(LAS u32x2*)(Kd + (kg + 8 * i) * KS_STR + piece * 8) = w; }
            { u32x4 w; w.x = cvt_pk_bf16(__uint_as_float(stg[8].x), __uint_as_float(stg[9].x)); w.y = cvt_pk_bf16(__uint_as_float(stg[10].x), __uint_as_float(stg[11].x)); w.z = cvt_pk_bf16(__uint_as_float(stg[12].x), __uint_as_float(stg[13].x)); w.w = cvt_pk_bf16(__uint_as_float(stg[14].x), __uint_as_float(stg[15].x)); *(LAS u32x4*)(Vd + (4 * piece + 0) * VT_STR + kg * 16) = w; }
            { u32x4 w; w.x = cvt_pk_bf16(__uint_as_float(stg[8].y), __uint_as_float(stg[9].y)); w.y = cvt_pk_bf16(__uint_as_float(stg[10].y), __uint_as_float(stg[11].y)); w.z = cvt_pk_bf16(__uint_as_float(stg[12].y), __uint_as_float(stg[13].y)); w.w = cvt_pk_bf16(__uint_as_float(stg[14].y), __uint_as_float(stg[15].y)); *(LAS u32x4*)(Vd + (4 * piece + 1) * VT_STR + kg * 16) = w; }
            { u32x4 w; w.x = cvt_pk_bf16(__uint_as_float(stg[8].z), __uint_as_float(stg[9].z)); w.y = cvt_pk_bf16(__uint_as_float(stg[10].z), __uint_as_float(stg[11].z)); w.z = cvt_pk_bf16(__uint_as_float(stg[12].z), __uint_as_float(stg[13].z)); w.w = cvt_pk_bf16(__uint_as_float(stg[14].z), __uint_as_float(stg[15].z)); *(LAS u32x4*)(Vd + (4 * piece + 2) * VT_STR + kg * 16) = w; }
            { u32x4 w; w.x = cvt_pk_bf16(__uint_as_float(stg[8].w), __uint_as_float(stg[9].w)); w.y = cvt_pk_bf16(__uint_as_float(stg[10].w), __uint_as_float(stg[11].w)); w.z = cvt_pk_bf16(__uint_as_float(stg[12].w), __uint_as_float(stg[13].w)); w.w = cvt_pk_bf16(__uint_as_float(stg[14].w), __uint_as_float(stg[15].w)); *(LAS u32x4*)(Vd + (4 * piece + 3) * VT_STR + kg * 16) = w; }
        } else {
#pragma unroll
            for (int i = 0; i < 4; ++i) *(LAS u32x4*)(Kd + ((tid >> 4) + 16 * i) * KS_STR + (tid & 15) * 16) = stg[i];
#pragma unroll
            for (int i = 0; i < 4; ++i) *(LAS u32x4*)(Vd + ((tid >> 3) + 32 * i) * VT_STR + (tid & 7) * 16) = stg[4 + i];
        }
    };
    issue(j0);
    __syncthreads();
    commit(j0, Ks, Vt);
    __syncthreads();
    for (int j = j0; j < j1; ++j) {
        const int cur = (j - j0) & 1;
        const LAS unsigned char* Kc = Ks + cur * 35840; const LAS unsigned char* Vc = Vt + cur * 35840;
        if (j + 1 < j1) issue(j + 1);
        __builtin_amdgcn_sched_barrier(0);
#pragma unroll
        for (int si = 0; si < 2; ++si) {
            f32x16 s;
#pragma unroll
            for (int g = 0; g < 16; ++g) s[g] = 0.f;
#pragma unroll
            for (int kk = 0; kk < 4; ++kk) { const bf16x8 kf = lds_rd16(Kc + (32 * si + pr) * KS_STR + (c * 64 + 16 * kk + 8 * hh) * 2); s = mfma32(kf, qf[kk], s); }
            const float dbase = qposh - (float)(64 * j + 32 * si);
#pragma unroll
            for (int g = 0; g < 16; ++g) {
                const float d = dbase - (float)((g & 3) + 4 * ((g >> 2) & 1) + 16 * (g >> 3));
                const float e = fexp2(__builtin_fmaf(-sl2, fabsf(d), s[g]) - C2);
                lsum += e; s[g] = e;
            }
#pragma unroll
            for (int st = 0; st < 2; ++st) {
                const bf16x8 pb = pack8(s, st);
#pragma unroll
                for (int dt = 0; dt < 4; ++dt) { const bf16x8 vf = lds_rd16(Vc + (32 * dt + r) * VT_STR + (32 * si + 16 * st + 8 * hh) * 2); O[dt] = mfma32(vf, pb, O[dt]); }
            }
        }
        __builtin_amdgcn_sched_barrier(0);
        if (j + 1 < j1) commit(j + 1, Ks + (cur ^ 1) * 35840, Vt + (cur ^ 1) * 35840);
        __syncthreads();
    }
    lsum += __shfl_xor(lsum, 32);
    __syncthreads();
    const bf16_t* SZA = (const bf16_t*)(p.ws + W_SZA); bf16_t* OAN = (bf16_t*)(p.ws + W_OAN);
    if (!samp) {
        LAS float* OX = (LAS float*)lds; LAS float* LX = (LAS float*)(lds + 67584);
#pragma unroll
        for (int dt = 0; dt < 4; ++dt)
#pragma unroll
            for (int g4 = 0; g4 < 4; ++g4)
                *(LAS f32x4*)(OX + (c * 64 + 32 * qh + r) * OX_STR + 32 * dt + 8 * g4 + 4 * hh) = (f32x4){O[dt][4 * g4], O[dt][4 * g4 + 1], O[dt][4 * g4 + 2], O[dt][4 * g4 + 3]};
        if (hh == 0) LX[c * 64 + 32 * qh + r] = lsum;
        __syncthreads();
        attn_finalize<true>((const float*)OX, (const float*)LX, 1, 0, 0, OX_STR, lam, p.subln_g, 0.8f, SZA, OAN, qrow0, h);
    } else {
        const int bh = b * 4 + h;
        const int slot0 = b * 4 * NSPLIT + slot_of(h), nsh = nsplit_of(h);
        float* PO = (float*)(p.ws + W_PO) + (size_t)slot0 * 2 * 64 * 128; float* PL = (float*)(p.ws + W_PL) + (size_t)slot0 * 128;
        float* po = PO + (size_t)idx * 2 * 64 * 128; float* pl = PL + idx * 128;
#pragma unroll
        for (int dt = 0; dt < 4; ++dt)
#pragma unroll
            for (int g4 = 0; g4 < 4; ++g4)
            {
                unsigned long long* q8 = (unsigned long long*)(po + (c * 64 + 32 * qh + r) * 128 + 32 * dt + 8 * g4 + 4 * hh);
                __hip_atomic_store(q8, ((unsigned long long)__float_as_uint(O[dt][4 * g4 + 1]) << 32) | __float_as_uint(O[dt][4 * g4]), __ATOMIC_RELAXED, __HIP_MEMORY_SCOPE_AGENT);
                __hip_atomic_store(q8 + 1, ((unsigned long long)__float_as_uint(O[dt][4 * g4 + 3]) << 32) | __float_as_uint(O[dt][4 * g4 + 2]), __ATOMIC_RELAXED, __HIP_MEMORY_SCOPE_AGENT);
            }
        if (hh == 0) __hip_atomic_store((unsigned*)(pl + c * 64 + 32 * qh + r), __float_as_uint(lsum), __ATOMIC_RELAXED, __HIP_MEMORY_SCOPE_AGENT);
        asm volatile("s_waitcnt vmcnt(0)" ::: "memory");
        __syncthreads();
        if (tid == 0) {
            const unsigned old = __hip_atomic_fetch_add((unsigned*)(p.ws + W_CTR) + bh, 1u, __ATOMIC_RELAXED, __HIP_MEMORY_SCOPE_AGENT);
            const unsigned last = (old == (unsigned)(nsh - 1)) ? 1u : 0u;
            if (last) { __builtin_amdgcn_fence(__ATOMIC_ACQUIRE, "agent"); asm volatile("s_waitcnt vmcnt(0)" ::: "memory"); }
            *(LAS unsigned*)(lds + SM_FLAG + 4) = last;
        }
        __syncthreads();
        if (*(LAS unsigned*)(lds + SM_FLAG + 4)) {
            attn_finalize<false>(PO, PL, nsh, 2 * 64 * 128, 128, 128, lam, p.subln_g, 0.8f, SZA, OAN, qrow0, h);
        }
    }
}

__device__ __forceinline__ void ret_item(const Params& p, LAS unsigned char* lds, bool samp, int b, int h, int grp) {
    const int tid = opaque_tid(), wid = tid >> 6, lane = tid & 63, r = lane & 31, hh = lane >> 5, dvb = 32 * wid;
    LAS unsigned char* Qs = lds; LAS unsigned char* Ks = lds + 17408; LAS unsigned char* Kt = lds + 34816; LAS unsigned char* Vt = lds + 53248;
    const int pr = pi32(r);
    LAS float* Ost = (LAS float*)lds;
    const bf16_t* QB = (const bf16_t*)(p.ws + W_QB); const bf16_t* KB = (const bf16_t*)(p.ws + W_KB);
    const bf16_t* KBT = (const bf16_t*)(p.ws + W_KBT); const bf16_t* VBT = (const bf16_t*)(p.ws + W_VBT);
    const bf16_t* SZB = (const bf16_t*)(p.ws + W_SZB); bf16_t* OBN = (bf16_t*)(p.ws + W_OBN);
    const float lg0 = log2_gamma(h), g64 = fexp2(64.0f * lg0);
    const int bh = b * 4 + h;
    f32x16 R[4];
    if (samp) {
        const float* sr = p.state_ret + (size_t)bh * 128 * 128;
#pragma unroll
        for (int di = 0; di < 4; ++di)
#pragma unroll
            for (int g = 0; g < 16; ++g) R[di][g] = sr[(32 * di + prow(g, hh)) * 128 + dvb + r];
    } else {
#pragma unroll
        for (int di = 0; di < 4; ++di)
#pragma unroll
            for (int g = 0; g < 16; ++g) R[di][g] = 0.f;
    }
    const int n0 = samp ? 0 : GC * grp, n1 = samp ? 1 : GC * grp + GC, rowbase = samp ? MP + b * 64 : b * 2048, tstr = samp ? 64 : 2048;
    const size_t tbase = samp ? TSAMP + (size_t)bh * 128 * 64 : (size_t)bh * 128 * 2048;
    for (int n = n0; n < n1; ++n) {
        __syncthreads();
        {
            const bf16_t* qp = QB + (size_t)(rowbase + 64 * n) * 512 + h * 128; const bf16_t* kp = KB + (size_t)(rowbase + 64 * n) * 512 + h * 128;
            const bf16_t* ktp = KBT + tbase + 64 * n; const bf16_t* vtp = VBT + tbase + 64 * n;
            u32x4 wq[4], wk[4], wkt[4], wvt[4];
#pragma unroll
            for (int i = 0; i < 4; ++i) { wq[i] = *(const u32x4*)(qp + (size_t)((tid >> 4) + 16 * i) * 512 + (tid & 15) * 8); wk[i] = *(const u32x4*)(kp + (size_t)((tid >> 4) + 16 * i) * 512 + (tid & 15) * 8); }
#pragma unroll
            for (int i = 0; i < 4; ++i) { wkt[i] = *(const u32x4*)(ktp + (size_t)((tid >> 3) + 32 * i) * tstr + (tid & 7) * 8); wvt[i] = *(const u32x4*)(vtp + (size_t)((tid >> 3) + 32 * i) * tstr + (tid & 7) * 8); }
#pragma unroll
            for (int i = 0; i < 4; ++i) { *(LAS u32x4*)(Qs + ((tid >> 4) + 16 * i) * KS_STR + (tid & 15) * 16) = wq[i]; *(LAS u32x4*)(Ks + ((tid >> 4) + 16 * i) * KS_STR + (tid & 15) * 16) = wk[i]; }
#pragma unroll
            for (int i = 0; i < 4; ++i) { *(LAS u32x4*)(Kt + ((tid >> 3) + 32 * i) * VT_STR + (tid & 7) * 16) = wkt[i]; *(LAS u32x4*)(Vt + ((tid >> 3) + 32 * i) * VT_STR + (tid & 7) * 16) = wvt[i]; }
        }
        __syncthreads();
        float lg = lg0; int hv = hh, rv = r; asm volatile("" : "+v"(lg), "+v"(hv), "+v"(rv));
        const float xb = (float)(4 * hv + 1), db = (float)(rv - 8 * hv);
        f32x16 o[2];
#pragma unroll
        for (int ti = 0; ti < 2; ++ti) {
            f32x16 acc;
#pragma unroll
            for (int g = 0; g < 16; ++g) acc[g] = 0.f;
            bf16x8 qf[8];
#pragma unroll
            for (int kk = 0; kk < 8; ++kk) qf[kk] = lds_rd16(Qs + (32 * ti + r) * KS_STR + (16 * kk + 8 * hh) * 2);
#pragma unroll
            for (int di = 0; di < 4; ++di)
#pragma unroll
                for (int st = 0; st < 2; ++st) acc = mfma32(qf[2 * di + st], pack8(R[di], st), acc);
#pragma unroll
            for (int g = 0; g < 16; ++g) acc[g] *= fexp2((xb + (float)(32 * ti + (g & 3) + 8 * (g >> 2))) * lg);
            __builtin_amdgcn_sched_barrier(0);
#pragma unroll
            for (int si = 0; si < 2; ++si) {
                f32x16 s;
#pragma unroll
                for (int g = 0; g < 16; ++g) s[g] = 0.f;
#pragma unroll
                for (int kk = 0; kk < 8; ++kk) {
                    const bf16x8 kf = lds_rd16(Ks + (32 * si + pr) * KS_STR + (16 * kk + 8 * hh) * 2);
                    s = mfma32(kf, qf[kk], s);
                }
#pragma unroll
                for (int g = 0; g < 16; ++g) s[g] *= fexp2(fabsf(db + (float)(32 * ti - 32 * si - (g & 3) - 4 * ((g >> 2) & 1) - 16 * (g >> 3))) * lg);
#pragma unroll
                for (int st = 0; st < 2; ++st) {
                    const bf16x8 ap = pack8(s, st);
                    const bf16x8 vf = lds_rd16(Vt + (dvb + r) * VT_STR + (32 * si + 16 * st + 8 * hh) * 2);
                    acc = mfma32(ap, vf, acc);
                }
                __builtin_amdgcn_sched_barrier(0);
            }
            o[ti] = acc;
        }
#pragma unroll
        for (int di = 0; di < 4; ++di) {
#pragma unroll
            for (int g = 0; g < 16; ++g) R[di][g] *= g64;
#pragma unroll
            for (int kk = 0; kk < 4; ++kk) {
                const bf16x8 af = lds_rd16(Kt + (32 * di + pr) * VT_STR + (16 * kk + 8 * hh) * 2);
                const bf16x8 vf = lds_rd16(Vt + (dvb + r) * VT_STR + (16 * kk + 8 * hh) * 2);
                R[di] = mfma32(af, vf, R[di]);
            }
        }
        __syncthreads();
#pragma unroll
        for (int ti = 0; ti < 2; ++ti)
#pragma unroll
            for (int g = 0; g < 16; ++g) Ost[(32 * ti + accrow(g, hh)) * OX_STR + dvb + r] = o[ti][g];
        __syncthreads();
        if (!samp) {
            const int t = tid >> 2, q = tid & 3;
            float* op = (float*)(p.ws + W_OP) + (size_t)(rowbase + 64 * n + t) * 512 + h * 128 + q * 32;
#pragma unroll
            for (int i = 0; i < 8; ++i) *(f32x4*)(op + 4 * i) = *(const LAS f32x4*)(Ost + t * OX_STR + q * 32 + 4 * i);
        } else {
            const int t = tid >> 2, q = tid & 3; f32x4 a[8]; float ss = 0.f;
#pragma unroll
            for (int i = 0; i < 8; ++i) { a[i] = *(const LAS f32x4*)(Ost + t * OX_STR + q * 32 + 4 * i); ss += a[i][0] * a[i][0] + a[i][1] * a[i][1] + a[i][2] * a[i][2] + a[i][3] * a[i][3]; }
            ss += __shfl_xor(ss, 1); ss += __shfl_xor(ss, 2);
            const float inv = rsqrtf(ss * (1.0f / 128.0f) + EPS);
            const size_t base = (size_t)(rowbase + 64 * n + t) * 512 + h * 128 + q * 32;
            u32x4 zz[4];
#pragma unroll
            for (int i = 0; i < 4; ++i) zz[i] = *(const u32x4*)(SZB + base + 8 * i);
            __builtin_amdgcn_sched_barrier(0);
#pragma unroll
            for (int i = 0; i < 4; ++i) {
                const u32x4 z = zz[i]; const f32x4 x0 = a[2 * i], x1 = a[2 * i + 1]; u32x4 w;
                w.x = cvt_pk_bf16(x0[0] * inv * bflo(z.x), x0[1] * inv * bfhi(z.x)); w.y = cvt_pk_bf16(x0[2] * inv * bflo(z.y), x0[3] * inv * bfhi(z.y));
                w.z = cvt_pk_bf16(x1[0] * inv * bflo(z.z), x1[1] * inv * bfhi(z.z)); w.w = cvt_pk_bf16(x1[2] * inv * bflo(z.w), x1[3] * inv * bfhi(z.w));
                *(u32x4*)(OBN + base + 8 * i) = w;
            }
        }
    }
    float* ro = samp ? p.out + O_RS + (size_t)bh * 128 * 128 : (float*)(p.ws + W_UG) + (size_t)(bh * NG + grp) * 128 * 128;
#pragma unroll
    for (int di = 0; di < 4; ++di)
#pragma unroll
        for (int g = 0; g < 16; ++g) ro[(32 * di + prow(g, hh)) * 128 + dvb + r] = R[di][g];
}

__device__ __forceinline__ void ret_fix_item(const Params& p, LAS unsigned char* lds, int bh, int grp, int c) {
    const int tid = opaque_tid(), wid = tid >> 6, lane = tid & 63, r = lane & 31, hh = lane >> 5, dvb = 32 * wid;
    const int b = bh >> 2, h = bh & 3;
    LAS float* Ost = (LAS float*)lds;
    const bf16_t* QB = (const bf16_t*)(p.ws + W_QB); const bf16_t* SZB = (const bf16_t*)(p.ws + W_SZB); bf16_t* OBN = (bf16_t*)(p.ws + W_OBN);
    const float* UG = (const float*)(p.ws + W_UG) + (size_t)bh * NG * 16384;
    const float* OP = (const float*)(p.ws + W_OP);
    const float lg = log2_gamma(h), g256 = fexp2((float)(64 * GC) * lg);
    const int row0 = b * 2048 + 64 * (GC * grp + c);
    f32x16 o[2];
    if (grp > 0) {
        float R0[64];
#pragma unroll
        for (int i = 0; i < 64; ++i) R0[i] = 0.f;
        for (int gp = 0; gp < grp; gp += 2) {
            const bool two = gp + 1 < grp;
            const float* u0 = UG + (size_t)gp * 16384 + (8 * hh) * 128 + dvb + r;
            const float* u1 = UG + (size_t)(two ? gp + 1 : gp) * 16384 + (8 * hh) * 128 + dvb + r;
            const float w1 = two ? 1.0f : 0.0f, w0 = two ? g256 : 1.0f, wr0 = two ? g256 * g256 : g256;
#pragma unroll
            for (int hf = 0; hf < 2; ++hf) {
                float ta[32], tb[32];
#pragma unroll
                for (int i = 0; i < 32; ++i) { ta[i] = u0[(16 * ((32 * hf + i) >> 3) + (i & 7)) * 128]; tb[i] = u1[(16 * ((32 * hf + i) >> 3) + (i & 7)) * 128]; }
                __builtin_amdgcn_sched_barrier(0);
#pragma unroll
                for (int i = 0; i < 32; ++i) R0[32 * hf + i] = R0[32 * hf + i] * wr0 + ta[i] * w0 + tb[i] * w1;
                __builtin_amdgcn_sched_barrier(0);
            }
        }
        if (grp == NG - 1 && c == GC - 1) {
            const float* u = UG + (size_t)(NG - 1) * 16384 + (8 * hh) * 128 + dvb + r;
            float* ro = p.out + O_RP + (size_t)bh * 16384 + (8 * hh) * 128 + dvb + r;
#pragma unroll
            for (int hf = 0; hf < 2; ++hf) {
                float tu[32];
#pragma unroll
                for (int i = 0; i < 32; ++i) tu[i] = u[(16 * ((32 * hf + i) >> 3) + (i & 7)) * 128];
                __builtin_amdgcn_sched_barrier(0);
#pragma unroll
                for (int i = 0; i < 32; ++i) ro[(16 * ((32 * hf + i) >> 3) + (i & 7)) * 128] = R0[32 * hf + i] * g256 + tu[i];
                __builtin_amdgcn_sched_barrier(0);
            }
        }
        bf16x8 rf[8];
#pragma unroll
        for (int kk = 0; kk < 8; ++kk) {
            u32x4 w; w.x = cvt_pk_bf16(R0[8 * kk + 0], R0[8 * kk + 1]); w.y = cvt_pk_bf16(R0[8 * kk + 2], R0[8 * kk + 3]);
            w.z = cvt_pk_bf16(R0[8 * kk + 4], R0[8 * kk + 5]); w.w = cvt_pk_bf16(R0[8 * kk + 6], R0[8 * kk + 7]);
            rf[kk] = __builtin_bit_cast(bf16x8, w);
        }
#pragma unroll
        for (int ti = 0; ti < 2; ++ti) {
            f32x16 acc;
#pragma unroll
            for (int g = 0; g < 16; ++g) acc[g] = 0.f;
            const bf16_t* qp = QB + (size_t)(row0 + 32 * ti + r) * 512 + h * 128 + 8 * hh;
            bf16x8 qf[8];
#pragma unroll
            for (int kk = 0; kk < 8; ++kk) qf[kk] = *(const bf16x8*)(qp + 16 * kk);
            __builtin_amdgcn_sched_barrier(0);
#pragma unroll
            for (int kk = 0; kk < 8; ++kk) acc = mfma32(qf[kk], rf[kk], acc);
#pragma unroll
            for (int g = 0; g < 16; ++g) acc[g] *= fexp2((float)(64 * c + 32 * ti + accrow(g, hh) + 1) * lg);
            o[ti] = acc;
        }
    } else {
#pragma unroll
        for (int ti = 0; ti < 2; ++ti)
#pragma unroll
            for (int g = 0; g < 16; ++g) o[ti][g] = 0.f;
    }
    __syncthreads();
#pragma unroll
    for (int ti = 0; ti < 2; ++ti)
#pragma unroll
        for (int g = 0; g < 16; ++g) Ost[(32 * ti + accrow(g, hh)) * OX_STR + dvb + r] = o[ti][g];
    __syncthreads();
    {
        const int t = tid >> 2, q = tid & 3; f32x4 a[8]; float ss = 0.f;
        const float* op = OP + (size_t)(row0 + t) * 512 + h * 128 + q * 32;
        const size_t base = (size_t)(row0 + t) * 512 + h * 128 + q * 32;
        f32x4 po[8]; u32x4 zz[4];
#pragma unroll
        for (int i = 0; i < 8; ++i) po[i] = *(const f32x4*)(op + 4 * i);
#pragma unroll
        for (int i = 0; i < 4; ++i) zz[i] = *(const u32x4*)(SZB + base + 8 * i);
        __builtin_amdgcn_sched_barrier(0);
#pragma unroll
        for (int i = 0; i < 8; ++i) { a[i] = *(const LAS f32x4*)(Ost + t * OX_STR + q * 32 + 4 * i) + po[i]; ss += a[i][0] * a[i][0] + a[i][1] * a[i][1] + a[i][2] * a[i][2] + a[i][3] * a[i][3]; }
        ss += __shfl_xor(ss, 1); ss += __shfl_xor(ss, 2);
        const float inv = rsqrtf(ss * (1.0f / 128.0f) + EPS);
#pragma unroll
        for (int i = 0; i < 4; ++i) {
            const u32x4 z = zz[i]; const f32x4 x0 = a[2 * i], x1 = a[2 * i + 1]; u32x4 w;
            w.x = cvt_pk_bf16(x0[0] * inv * bflo(z.x), x0[1] * inv * bfhi(z.x)); w.y = cvt_pk_bf16(x0[2] * inv * bflo(z.y), x0[3] * inv * bfhi(z.y));
            w.z = cvt_pk_bf16(x1[0] * inv * bflo(z.z), x1[1] * inv * bfhi(z.z)); w.w = cvt_pk_bf16(x1[2] * inv * bflo(z.w), x1[3] * inv * bfhi(z.w));
            *(u32x4*)(OBN + base + 8 * i) = w;
        }
    }
}
__device__ void phase2b(const Params& p, LAS unsigned char* lds) {
    if (blockIdx.x < 32) {
        const int pm = 128 + (blockIdx.x >> 3), pn = blockIdx.x & 7;
        unsigned* c3 = (unsigned*)(p.ws + W_CTR) + 56 + (blockIdx.x >> 3);
        p3a_tile<true>(p, lds, pm, pn);
        asm volatile("s_waitcnt vmcnt(0)" ::: "memory");
        __syncthreads();
        if (threadIdx.x == 0) {
            __hip_atomic_fetch_add(c3, 1u, __ATOMIC_RELAXED, __HIP_MEMORY_SCOPE_AGENT);
            while (__hip_atomic_load(c3, __ATOMIC_RELAXED, __HIP_MEMORY_SCOPE_AGENT) < 8u) __builtin_amdgcn_s_sleep(2);
            __builtin_amdgcn_fence(__ATOMIC_ACQUIRE, "agent");
            asm volatile("s_waitcnt vmcnt(0)" ::: "memory");
        }
        __syncthreads();
        p3b_tile(p, lds, pm, pn);
        return;
    }
    const int nb = gridDim.x - 32;
    for (int it = blockIdx.x - 32; it < 1024; it += nb) ret_fix_item(p, lds, it & 31, it < 512 ? (NG - 1) - ((it >> 5) & (NG - 1)) : ((it >> 5) & (NG - 1)), (it >> 7) & (GC - 1));
}

constexpr int NRET = 32 * NG + 32;
constexpr int NITEMS = NRET + 32 * NSPLIT + 1024;
__device__ void phase2(const Params& p, LAS unsigned char* lds) {
    unsigned* ctr = (unsigned*)(p.ws + W_CTR);
    for (;;) {
        __syncthreads();
        if (threadIdx.x == 0) *(LAS int*)(lds + SM_FLAG) = (int)atomicAdd(ctr + 32, 1u);
        __syncthreads();
        const int it = *(LAS int*)(lds + SM_FLAG);
        if (it >= NITEMS) break;
        if (it < NRET) { const bool samp = it >= 32 * NG; const int bh = samp ? it - 32 * NG : it / NG; ret_item(p, lds, samp, bh >> 2, bh & 3, it % NG); }
        else {
            bool samp; int bh, idx;
            if (it < NRET + 32 * NSPLIT) { samp = true; const int kk = it - NRET, bb = kk / 24, s = kk % 24, hs = s < 2 ? 0 : s < 6 ? 1 : s < 15 ? 2 : 3; bh = bb * 4 + hs; idx = s - slot_of(hs); }
            else { samp = false; const int k = it - NRET - 32 * NSPLIT; idx = 31 - (k >> 5); bh = k & 31; }
            attn_item(p, lds, samp, bh >> 2, bh & 3, idx);
        }
    }
}

#define XB_TMO      128
#define XB_XCNT(j)  (256  + 64 * (j))
#define XB_XSUB(j)  (1280 + 64 * (j))
#define XB_XGEN(j)  (2304 + 64 * (j))
#define XB_TOP      3328
#define XB_TOPGEN   3392
#define XCD_BAR_WORDS 3456
#define XB_SPIN_CAP (1u << 18)

__device__ __forceinline__ unsigned xb_ld(unsigned* p)              { return __hip_atomic_load(p, __ATOMIC_RELAXED, __HIP_MEMORY_SCOPE_AGENT); }
__device__ __forceinline__ unsigned xb_add(unsigned* p, unsigned v) { return __hip_atomic_fetch_add(p, v, __ATOMIC_RELAXED, __HIP_MEMORY_SCOPE_AGENT); }
__device__ __forceinline__ unsigned xb_xcc_id() { return (unsigned)__builtin_amdgcn_s_getreg((3 << 11) | 20) & 0xFu; }
#define XB_SPIN(cond, bar) do { unsigned _sp = 0; while (cond) { __builtin_amdgcn_s_sleep(1); \
    if ((++_sp & 255u) == 0u) { if (xb_ld(&(bar)[XB_TMO])) break; if (_sp > XB_SPIN_CAP) { atomicAdd(&(bar)[XB_TMO], 1u); break; } } } } while (0)

struct XcdBarrier {
    unsigned* bar; unsigned x;
    volatile LAS unsigned* st;
};

__device__ __forceinline__ XcdBarrier xcd_barrier_post(unsigned* bar, volatile LAS unsigned* st) {
    XcdBarrier b; b.bar = bar; b.x = xb_xcc_id(); b.st = st;
    if (threadIdx.x == 0) (void)xb_add(&bar[XB_XCNT(b.x)], 1u);
    return b;
}
__device__ __forceinline__ void xcd_barrier_complete(unsigned* bar, unsigned x, unsigned& nloc, unsigned& nx) {
    const unsigned G = gridDim.x * gridDim.y * gridDim.z;
    unsigned sum, cnt, mine, sp = 0u;
    for (;;) {
        sum = 0u; cnt = 0u; mine = 0u;
#pragma unroll
        for (unsigned j = 0; j < 16; ++j) { const unsigned c = xb_ld(&bar[XB_XCNT(j)]); sum += c; cnt += (c > 0u) ? 1u : 0u; mine = (j == x) ? c : mine; }
        if (sum == G) break;
        __builtin_amdgcn_s_sleep(1);
        if ((++sp & 255u) == 0u) { if (xb_ld(&bar[XB_TMO])) break; if (sp > XB_SPIN_CAP) { atomicAdd(&bar[XB_TMO], 1u); break; } }
    }
    nloc = mine > 0u ? mine : 1u; nx = cnt > 0u ? cnt : 1u;
}

__device__ __forceinline__ void xcd_barrier(const XcdBarrier& b) {
    asm volatile("s_waitcnt vmcnt(0)" ::: "memory");
    __syncthreads();
    if (threadIdx.x == 0) {
        unsigned* bar = b.bar;
        __builtin_amdgcn_s_waitcnt(0);
        unsigned nloc = b.st[0], nx = b.st[1];
        if (nloc == 0u) { xcd_barrier_complete(bar, b.x, nloc, nx); b.st[0] = nloc; b.st[1] = nx; }
        const unsigned old = xb_add(&bar[XB_XSUB(b.x)], 1u);
        const unsigned gen = old / nloc;
        if (old + 1u == (gen + 1u) * nloc) {
            __builtin_amdgcn_fence(__ATOMIC_RELEASE, "agent");
            asm volatile("s_waitcnt vmcnt(0)" ::: "memory");
            const unsigned og = xb_add(&bar[XB_TOP], 1u);
            const unsigned tg = og / nx;
            if (og + 1u == (tg + 1u) * nx) xb_add(&bar[XB_TOPGEN], 1u);
            else XB_SPIN(xb_ld(&bar[XB_TOPGEN]) == tg, bar);
            __builtin_amdgcn_fence(__ATOMIC_ACQUIRE, "agent");
            xb_add(&bar[XB_XGEN(b.x)], 1u);
            asm volatile("s_waitcnt vmcnt(0)" ::: "memory");
        } else {
            XB_SPIN(xb_ld(&bar[XB_XGEN(b.x)]) == gen, bar);
            __builtin_amdgcn_fence(__ATOMIC_ACQUIRE, "agent");
            asm volatile("s_waitcnt vmcnt(0)" ::: "memory");
        }
    }
    __syncthreads();
}


__global__ void __launch_bounds__(256, 2) hybrid_fwd(Params p, int ph_lo, int ph_hi) {
    __shared__ __attribute__((aligned(16))) unsigned char smem[SMEM];
    LAS unsigned char* lds = (LAS unsigned char*)smem;
    cg::grid_group grid = cg::this_grid();
    if (threadIdx.x < 2) *(LAS unsigned*)(lds + SM_FLAG + 16 + 4 * threadIdx.x) = 0u;
    __syncthreads();
    const XcdBarrier xb = xcd_barrier_post((unsigned*)(p.ws + W_BAR), (volatile LAS unsigned*)(lds + SM_FLAG + 16));
#define RUN_PHASE(k, call) if (ph_lo <= (k) && (k) <= ph_hi) { call; if ((k) < ph_hi) { if (ph_hi > 1000) grid.sync(); else xcd_barrier(xb); } }
    RUN_PHASE(0, phase0(p, lds))
    RUN_PHASE(1, phase1(p, lds))
    RUN_PHASE(2, phase2(p, lds))
    RUN_PHASE(3, phase2b(p, lds))
    RUN_PHASE(4, phase3a(p, lds))
    RUN_PHASE(5, phase3b(p, lds))
#undef RUN_PHASE
}

extern "C" void kernel_launch(void* const* d_in, const int* in_sizes, int n_in, void* d_out, int out_size, void* d_ws, size_t ws_size, hipStream_t stream) {
    (void)in_sizes; (void)n_in; (void)out_size;
    static int grid_blocks = 0;
    if (!grid_blocks) {
        int dev = 0, cus = 0, per_cu = 0;
        hipGetDevice(&dev);
        hipDeviceGetAttribute(&cus, hipDeviceAttributeMultiprocessorCount, dev);
        hipOccupancyMaxActiveBlocksPerMultiprocessor(&per_cu, hybrid_fwd, 256, 0);
        if (per_cu > 2) per_cu = 2;
        if (per_cu < 1) per_cu = 1;
        grid_blocks = cus * per_cu;
    }
    if (ws_size < W_END) { fprintf(stderr, "workspace too small: %zu < %zu\n", ws_size, (size_t)W_END); return; }
    Params p{};
    p.x_prompt = (const float*)d_in[0]; p.x_sample = (const float*)d_in[1]; p.cache_k = (const float*)d_in[2]; p.cache_v = (const float*)d_in[3];
    p.state_ret = (const float*)d_in[4]; p.norm_g = (const float*)d_in[5]; p.w_in = (const float*)d_in[6]; p.b_gate = (const float*)d_in[7];
    p.qn_g = (const float*)d_in[8]; p.kn_g = (const float*)d_in[9]; p.lam_q1 = (const float*)d_in[10]; p.lam_k1 = (const float*)d_in[11];
    p.lam_q2 = (const float*)d_in[12]; p.lam_k2 = (const float*)d_in[13]; p.subln_g = (const float*)d_in[14]; p.w_oa = (const float*)d_in[15];
    p.w_ob = (const float*)d_in[16]; p.w_out = (const float*)d_in[17];
    p.out = (float*)d_out; p.ws = (unsigned char*)d_ws;
    hipMemsetAsync((unsigned char*)d_ws + W_BAR, 0, 3456 * 4, stream);
    int lo = 0, hi = 5;
    void* args[] = {&p, &lo, &hi};
    hipError_t e = hipLaunchCooperativeKernel((void*)hybrid_fwd, dim3(grid_blocks), dim3(256), args, 0, stream);
    if (e != hipSuccess) fprintf(stderr, "cooperative launch failed: %s (grid %d)\n", hipGetErrorString(e), grid_blocks);
}
```
